# Optimizing an MI355X kernel written in HIP

```python
import math
import jax, jax.numpy as jnp
from jax import lax
import numpy as np

D_MODEL = 1024
BATCH = 16
SEQ = 2048
DEPTH = 2
DEC_BATCH = 32
DEC_SEQ = 2048
PAST_LEN = 128

RET_HEADS = 4
RET_HEAD_DIM = 128
RET_WIDTH = RET_HEADS * RET_HEAD_DIM
DIFF_HEADS = 4
DIFF_HEAD_DIM = 64
DIFF_V_DIM = 2 * DIFF_HEAD_DIM
DIFF_WIDTH = DIFF_HEADS * DIFF_V_DIM
MIX_WIDTH = RET_WIDTH + DIFF_WIDTH
IN_COLS = 4 * RET_WIDTH + 3 * DIFF_WIDTH
D_FF = 2816
CHUNK = 128
Q_BLOCK = 128
REL_BUCKETS = 32
REL_MAX_DIST = 128
ROPE_BASE = 10000.0
EPS = 1e-6

kernel_name = "hybrid_retention_diffattn_macaron_encoder"


def _rmsnorm(x, g):
    xf = x.astype(jnp.float32)
    y = xf * lax.rsqrt(jnp.mean(xf * xf, axis=-1, keepdims=True) + EPS)
    return (y * g.astype(jnp.float32)).astype(x.dtype)


def _swiglu(x, wg, wu, wd):
    return (jax.nn.silu(x @ wg) * (x @ wu)) @ wd


def _rotary(x, pos):
    half = x.shape[-1] // 2
    inv = ROPE_BASE ** (-jnp.arange(half, dtype=jnp.float32) / half)
    ang = pos[:, None] * inv[None, :]
    cos = jnp.cos(ang)[None, :, None, :].astype(x.dtype)
    sin = jnp.sin(ang)[None, :, None, :].astype(x.dtype)
    x1, x2 = x[..., :half], x[..., half:]
    return jnp.concatenate([x1 * cos - x2 * sin, x1 * sin + x2 * cos], axis=-1)


def _retention_one_dir(q, k, v, log_gamma, strict):
    dt = q.dtype
    idx = jnp.arange(CHUNK, dtype=jnp.float32)
    rel = idx[:, None] - idx[None, :]
    mask = (rel > 0) if strict else (rel >= 0)
    expo = jnp.where(mask[None], rel[None] * log_gamma[:, None, None], 0.0)
    decay = jnp.where(mask[None], jnp.exp(expo), 0.0).astype(dt)
    scores = jnp.einsum('bhncd,bhnmd->bhncm', q, k) * decay[None, :, None]
    inner = jnp.einsum('bhncm,bhnme->bhnce', scores, v)
    zeta = jnp.exp((CHUNK - 1 - idx)[None, :] * log_gamma[:, None]).astype(dt)
    xi = jnp.exp((idx + 1)[None, :] * log_gamma[:, None]).astype(dt)
    chunk_kv = jnp.einsum('bhnmd,bhnme->nbhde', k * zeta[None, :, None, :, None], v).astype(jnp.float32)
    g_chunk = jnp.exp(CHUNK * log_gamma)[None, :, None, None]

    def step(state, kv):
        return kv + g_chunk * state, state

    init = jnp.zeros(chunk_kv.shape[1:], jnp.float32)
    _, prev = lax.scan(step, init, chunk_kv)
    cross = jnp.einsum('bhncd,nbhde->bhnce', q * xi[None, :, None, :, None], prev.astype(dt))
    return inner + cross


def _retention(rq, rk, rv, rg, decay_logit, gn_g):
    B, L, _ = rq.shape
    nc = L // CHUNK
    pos = jnp.arange(L, dtype=jnp.float32)
    q = _rotary(rq.reshape(B, L, RET_HEADS, RET_HEAD_DIM), pos)
    k = _rotary(rk.reshape(B, L, RET_HEADS, RET_HEAD_DIM), pos) * (RET_HEAD_DIM ** -0.5)
    v = rv.reshape(B, L, RET_HEADS, RET_HEAD_DIM)

    def to_chunks(t):
        return t.reshape(B, nc, CHUNK, RET_HEADS, RET_HEAD_DIM).transpose(0, 3, 1, 2, 4)

    qc, kc, vc = to_chunks(q), to_chunks(k), to_chunks(v)
    log_gamma = jax.nn.log_sigmoid(decay_logit.astype(jnp.float32))
    flip = lambda t: t[:, :, ::-1, ::-1]
    fwd = _retention_one_dir(qc, kc, vc, log_gamma[0], False)
    bwd = flip(_retention_one_dir(flip(qc), flip(kc), flip(vc), log_gamma[1], True))
    o = (fwd + bwd).transpose(0, 2, 3, 1, 4).reshape(B, L, RET_HEADS, RET_HEAD_DIM)
    of = o.astype(jnp.float32)
    mu = jnp.mean(of, axis=-1, keepdims=True)
    var = jnp.mean(jnp.square(of - mu), axis=-1, keepdims=True)
    on = ((of - mu) * lax.rsqrt(var + EPS)).reshape(B, L, RET_WIDTH) * gn_g.astype(jnp.float32)
    return jax.nn.silu(rg) * on.astype(rg.dtype)


def _rel_bucket(rel):
    half = REL_BUCKETS // 2
    max_exact = half // 2
    sign = (rel > 0).astype(jnp.int32) * half
    n = jnp.abs(rel)
    nf = jnp.maximum(n, 1).astype(jnp.float32)
    large = max_exact + (jnp.log(nf / max_exact) / math.log(REL_MAX_DIST / max_exact)
                         * (half - max_exact)).astype(jnp.int32)
    large = jnp.minimum(large, half - 1)
    return sign + jnp.where(n < max_exact, n, large)


def _diff_attn(dq, dk, dv, qn_g, kn_g, lam_vec, subln_g, rel_table, lam_init):
    B, L, _ = dq.shape
    dt = dq.dtype
    q = _rmsnorm(dq.reshape(B, L, DIFF_HEADS, 2, DIFF_HEAD_DIM), qn_g).transpose(0, 2, 3, 1, 4)
    k = _rmsnorm(dk.reshape(B, L, DIFF_HEADS, 2, DIFF_HEAD_DIM), kn_g).transpose(0, 2, 3, 1, 4)
    v = dv.reshape(B, L, DIFF_HEADS, DIFF_V_DIM).transpose(0, 2, 1, 3)
    lv = lam_vec.astype(jnp.float32)
    lam = jnp.exp(jnp.sum(lv[0] * lv[1])) - jnp.exp(jnp.sum(lv[2] * lv[3])) + lam_init
    scale = DIFF_HEAD_DIM ** -0.5
    nb = L // Q_BLOCK
    q_blocks = q.reshape(B, DIFF_HEADS, 2, nb, Q_BLOCK, DIFF_HEAD_DIM).transpose(3, 0, 1, 2, 4, 5)
    starts = jnp.arange(nb, dtype=jnp.int32) * Q_BLOCK
    k_pos = jnp.arange(L, dtype=jnp.int32)

    def block(args):
        qb, s0 = args
        q_pos = s0 + jnp.arange(Q_BLOCK, dtype=jnp.int32)
        bucket = _rel_bucket(k_pos[None, :] - q_pos[:, None])
        bias = rel_table.astype(jnp.float32)[bucket].transpose(2, 0, 1)
        logits = jnp.einsum('bhtqd,bhtkd->bhtqk', qb, k).astype(jnp.float32) * scale + bias[None, :, None]
        p = jax.nn.softmax(logits, axis=-1)
        a = (p[:, :, 0] - lam * p[:, :, 1]).astype(dt)
        return jnp.einsum('bhqk,bhke->bhqe', a, v)

    out = lax.map(block, (q_blocks, starts))
    out = out.transpose(1, 0, 3, 2, 4).reshape(B, L, DIFF_HEADS, DIFF_V_DIM)
    out = _rmsnorm(out, subln_g) * (1.0 - lam_init)
    return out.reshape(B, L, DIFF_WIDTH)


def _trunk(x, ffn1_norm, ffn1_wg, ffn1_wu, ffn1_wd, mix_norm, w_in, ret_decay_logit, ret_gn_g,
           diff_qn_g, diff_kn_g, diff_lambda, diff_subln_g, rel_bias_table, w_out,
           ffn2_norm, ffn2_wg, ffn2_wu, ffn2_wd, final_norm):
    splits = [RET_WIDTH, 2 * RET_WIDTH, 3 * RET_WIDTH, 4 * RET_WIDTH,
              4 * RET_WIDTH + DIFF_WIDTH, 4 * RET_WIDTH + 2 * DIFF_WIDTH]
    for l in range(DEPTH):
        lam_init = 0.8 - 0.6 * math.exp(-0.3 * l)
        h = x + 0.5 * _swiglu(_rmsnorm(x, ffn1_norm[l]), ffn1_wg[l], ffn1_wu[l], ffn1_wd[l])
        u = _rmsnorm(h, mix_norm[l])
        p = u @ w_in[l]
        rq, rk, rv, rg, dq, dk, dv = jnp.split(p, splits, axis=-1)
        ret = _retention(rq, rk, rv, rg, ret_decay_logit[l], ret_gn_g[l])
        dif = _diff_attn(dq, dk, dv, diff_qn_g[l], diff_kn_g[l], diff_lambda[l], diff_subln_g[l],
                         rel_bias_table, lam_init)
        h = h + jnp.concatenate([ret, dif], axis=-1) @ w_out[l]
        h = h + 0.5 * _swiglu(_rmsnorm(h, ffn2_norm[l]), ffn2_wg[l], ffn2_wu[l], ffn2_wd[l])
        x = _rmsnorm(h, final_norm[l])
    return x


def setup_inputs(seed: int = 0) -> dict:
    key = jax.random.key(seed)
    ks = jax.random.split(key, 24)
    f32 = jnp.float32
    nrm = lambda k, s, sc: jax.random.normal(k, s, f32) * sc
    gain = lambda k, s: 1.0 + 0.02 * jax.random.normal(k, s, f32)
    gamma = 1.0 - 2.0 ** (-5.0 - np.arange(RET_HEADS, dtype=np.float32))
    base_logit = jnp.asarray(np.log(gamma / (1.0 - gamma)), f32)
    decay_logit = jnp.broadcast_to(base_logit, (DEPTH, 2, RET_HEADS)) + 0.01 * jax.random.normal(ks[8], (DEPTH, 2, RET_HEADS), f32)
    return {
        "x_prompt": jax.random.normal(ks[0], (BATCH, SEQ, D_MODEL), f32),
        "x_sample": jax.random.normal(ks[1], (DEC_BATCH, DEC_SEQ, D_MODEL), f32),
        "ffn1_norm": gain(ks[2], (DEPTH, D_MODEL)),
        "ffn1_wg": nrm(ks[3], (DEPTH, D_MODEL, D_FF), D_MODEL ** -0.5),
        "ffn1_wu": nrm(ks[4], (DEPTH, D_MODEL, D_FF), D_MODEL ** -0.5),
        "ffn1_wd": nrm(ks[5], (DEPTH, D_FF, D_MODEL), D_FF ** -0.5),
        "mix_norm": gain(ks[6], (DEPTH, D_MODEL)),
        "w_in": nrm(ks[7], (DEPTH, D_MODEL, IN_COLS), D_MODEL ** -0.5),
        "ret_decay_logit": decay_logit,
        "ret_gn_g": gain(ks[9], (DEPTH, RET_WIDTH)),
        "diff_qn_g": gain(ks[10], (DEPTH, 2, DIFF_HEAD_DIM)),
        "diff_kn_g": gain(ks[11], (DEPTH, 2, DIFF_HEAD_DIM)),
        "diff_lambda": nrm(ks[12], (DEPTH, 4, DIFF_HEAD_DIM), 0.1),
        "diff_subln_g": gain(ks[13], (DEPTH, DIFF_V_DIM)),
        "rel_bias_table": nrm(ks[14], (REL_BUCKETS, DIFF_HEADS), 0.1),
        "w_out": nrm(ks[15], (DEPTH, MIX_WIDTH, D_MODEL), MIX_WIDTH ** -0.5),
        "ffn2_norm": gain(ks[16], (DEPTH, D_MODEL)),
        "ffn2_wg": nrm(ks[17], (DEPTH, D_MODEL, D_FF), D_MODEL ** -0.5),
        "ffn2_wu": nrm(ks[18], (DEPTH, D_MODEL, D_FF), D_MODEL ** -0.5),
        "ffn2_wd": nrm(ks[19], (DEPTH, D_FF, D_MODEL), D_FF ** -0.5),
        "final_norm": gain(ks[20], (DEPTH, D_MODEL)),
    }


def reference(x_prompt, x_sample, ffn1_norm, ffn1_wg, ffn1_wu, ffn1_wd, mix_norm, w_in,
              ret_decay_logit, ret_gn_g, diff_qn_g, diff_kn_g, diff_lambda, diff_subln_g,
              rel_bias_table, w_out, ffn2_norm, ffn2_wg, ffn2_wu, ffn2_wd, final_norm):
    y_prompt = _trunk(x_prompt, ffn1_norm, ffn1_wg, ffn1_wu, ffn1_wd, mix_norm, w_in, ret_decay_logit,
                      ret_gn_g, diff_qn_g, diff_kn_g, diff_lambda, diff_subln_g, rel_bias_table, w_out,
                      ffn2_norm, ffn2_wg, ffn2_wu, ffn2_wd, final_norm)
    y_sample = _trunk(x_sample, ffn1_norm, ffn1_wg, ffn1_wu, ffn1_wd, mix_norm, w_in, ret_decay_logit,
                      ret_gn_g, diff_qn_g, diff_kn_g, diff_lambda, diff_subln_g, rel_bias_table, w_out,
                      ffn2_norm, ffn2_wg, ffn2_wu, ffn2_wd, final_norm)
    return (y_prompt, y_sample)
```

```cpp
#include <hip/hip_runtime.h>
#include <hip/hip_cooperative_groups.h>
#include <cstdio>
#include <cstdint>
namespace cg = cooperative_groups;
namespace pg8 {
#define PG8_LAS __attribute__((address_space(3)))
typedef unsigned short bf16_t;
typedef short bf16x8 __attribute__((ext_vector_type(8)));
typedef float f32x4 __attribute__((ext_vector_type(4)));
typedef unsigned u32x4 __attribute__((ext_vector_type(4)));
constexpr int BM = 256, BK = 64, HALF = 128, HTB = HALF * BK * 2  , STAGE_BYTES = 8 * HTB, NXCD = 8, WGM = 8;

__host__ __device__ __forceinline__ int lds_byte(int r, int c) { const int st = (r >> 4) * 2 + (c >> 5), rr = r & 15, cc = c & 31, ob = rr * 64 + cc * 2; return st * 1024 + (ob ^ (((ob >> 9) & 1) << 5)); }
__host__ __device__ __forceinline__ void stage_rc(int b, int& R, int& C) { const int st = b / 1024, sb = b % 1024, swz = sb ^ (((sb >> 9) & 1) << 5); R = (st >> 1) * 16 + swz / 64; C = (st & 1) * 32 + (swz % 64) / 2; }
__host__ __device__ __forceinline__ int perm32(int rho) { const int n = rho >> 4, i = rho & 15; return 8 * (i >> 2) + 4 * n + (i & 3); }

struct Unit { int pm, pn; };
struct Gemm { const bf16_t* A; const bf16_t* Bt; int M, N, K, lda; };

struct StaticOrder {
    int nM, nN, nwg, G, c;
    __host__ __device__ void init(int M, int N, int G_, int c_) { nM = M / BM; nN = N / BM; nwg = nM * nN; G = G_; c = c_; }
    __host__ __device__ bool next(int i, Unit& u) const {
        const long L = (long)i * G + c; if (L >= nwg) return false;
        int wgid = (int)L; { const int q = nwg / NXCD, r = nwg % NXCD, xcd = wgid % NXCD, off = wgid / NXCD; wgid = (xcd < r ? xcd * (q + 1) : r * (q + 1) + (xcd - r) * q) + off; }
        const int nig = WGM * nN, gid = wgid / nig, fm = gid * WGM, gsz = (nM - fm) < WGM ? (nM - fm) : WGM;
        u.pm = fm + ((wgid % nig) % gsz); u.pn = (wgid % nig) / gsz; return true;
    }
    __device__ __forceinline__ void a_ready(const Unit&) const {}
    __device__ __forceinline__ void done(const Unit&) const {}
};

__device__ __forceinline__ unsigned cvt_pk_bf16(float lo, float hi) { unsigned r; asm volatile("v_cvt_pk_bf16_f32 %0, %1, %2" : "=v"(r) : "v"(lo), "v"(hi)); return r; }
typedef float f32x2 __attribute__((ext_vector_type(2)));
template <class Epi, class Sched, bool ALIGN_EPI = false, bool SP2 = false>
__device__ __forceinline__ void gemm_phase(PG8_LAS unsigned char* lds, const Gemm g, const Sched& S, const Epi& E, const int tid) {
    const int wid = __builtin_amdgcn_readfirstlane(tid >> 6), lane = tid & 63, wr = wid >> 2, wc = wid & 3, fr = lane & 15, fq = lane >> 4;
    const int K = g.K, nt = K / BK;
    unsigned voffA[2], voffB[2];
#pragma unroll
    for (int i = 0; i < 2; ++i) { int R, C; stage_rc(tid * 16 + i * 8192, R, C); const int Rb = Epi::PERM ? ((R & ~31) + perm32(R & 31)) : R;
        voffA[i] = (unsigned)(R * g.lda + C) * 2u; voffB[i] = (unsigned)(Rb * K + C) * 2u; }
    const size_t kstep = (size_t)(BK * 2);
    const size_t hstep = (size_t)HALF * K * 2;
    const size_t tstep = 2 * hstep; const size_t hstepA = (size_t)HALF * g.lda * 2, tstepA = 2 * hstepA;
    const unsigned ldsw = (unsigned)wid * 1024u;
    const int aoff = lds_byte(wr * 64 + fr, fq * 8), boff = lds_byte(wc * 32 + fr, fq * 8);
#define PG8_SA(b, h) (((b) * 2 + (h)) * HTB)
#define PG8_SB(b, h) ((4 + (b) * 2 + (h)) * HTB)
#define PG8_STAGE(bufoff, gbase, voff) do { _Pragma("unroll") for (int _i = 0; _i < 2; ++_i) \
        __builtin_amdgcn_global_load_lds((const unsigned*)((const char*)(gbase) + (voff)[_i]), (PG8_LAS unsigned*)(lds + (bufoff) + ldsw + _i * 8192), 16, 0, 0); } while (0)
#define PG8_LDA(dst, b, h) do { _Pragma("unroll") for (int m = 0; m < 4; ++m) _Pragma("unroll") for (int k = 0; k < 2; ++k) dst[m][k] = *(const PG8_LAS bf16x8*)(lds + PG8_SA(b, h) + aoff + m * 2048 + k * 1024); } while (0)
#define PG8_LDB(dst, b, h) do { _Pragma("unroll") for (int n = 0; n < 2; ++n) _Pragma("unroll") for (int k = 0; k < 2; ++k) dst[n][k] = *(const PG8_LAS bf16x8*)(lds + PG8_SB(b, h) + boff + n * 2048 + k * 1024); } while (0)
#define PG8_MMA(ai, bj, At, Bt) do { __builtin_amdgcn_s_setprio(1); _Pragma("unroll") for (int m = 0; m < 4; ++m) _Pragma("unroll") for (int n = 0; n < 2; ++n) _Pragma("unroll") for (int k = 0; k < 2; ++k) \
        acc[ai][bj][m][n] = __builtin_amdgcn_mfma_f32_16x16x32_bf16(Bt[n][k], At[m][k], acc[ai][bj][m][n], 0, 0, 0); __builtin_amdgcn_s_setprio(0); } while (0)
#define PG8_WAIT_V(n) asm volatile("s_waitcnt vmcnt(" #n ")" ::: "memory")
#define PG8_WAIT_L(n) asm volatile("s_waitcnt lgkmcnt(" #n ")" ::: "memory")
#define PG8_BAR __builtin_amdgcn_s_barrier()
#define PG8_SCHED __builtin_amdgcn_sched_barrier(0)
    Unit cur, nxt; int ui = 0;
    if (!S.next(0, cur)) return;
    f32x4 acc[2][2][4][2];
#pragma unroll
    for (int a = 0; a < 2; ++a)
#pragma unroll
        for (int b = 0; b < 2; ++b)
#pragma unroll
            for (int m = 0; m < 4; ++m)
#pragma unroll
                for (int n = 0; n < 2; ++n) acc[a][b][m][n] = (f32x4){0.f, 0.f, 0.f, 0.f};
    bf16x8 At[4][2], B0[2][2], B1[2][2];
    const char* cA = (const char*)g.A + (size_t)cur.pm * tstepA; const char* cB = (const char*)g.Bt + (size_t)cur.pn * tstep;
    S.a_ready(cur);
    if constexpr (SP2) {
        PG8_STAGE(PG8_SB(0, 0), cB, voffB); PG8_STAGE(PG8_SB(0, 1), cB + hstep, voffB); PG8_STAGE(PG8_SA(0, 0), cA, voffA); PG8_STAGE(PG8_SA(0, 1), cA + hstepA, voffA);
        if (wr == 1) PG8_BAR;
        PG8_WAIT_V(2); PG8_BAR;
        PG8_STAGE(PG8_SB(1, 0), cB + kstep, voffB); PG8_STAGE(PG8_SA(1, 0), cA + kstep, voffA); PG8_STAGE(PG8_SB(1, 1), cB + hstep + kstep, voffB);
        PG8_WAIT_V(6); PG8_BAR;
    } else {
        PG8_STAGE(PG8_SB(0, 0), cB, voffB); PG8_STAGE(PG8_SA(0, 0), cA, voffA); PG8_STAGE(PG8_SB(0, 1), cB + hstep, voffB); PG8_STAGE(PG8_SA(0, 1), cA + hstepA, voffA);
        if (wr == 1) PG8_BAR;
        PG8_WAIT_V(4); PG8_BAR;
        PG8_STAGE(PG8_SB(1, 0), cB + kstep, voffB); PG8_STAGE(PG8_SA(1, 0), cA + kstep, voffA); PG8_STAGE(PG8_SB(1, 1), cB + hstep + kstep, voffB);
        PG8_WAIT_V(6); PG8_BAR;
    }
    for (;;) {
        const bool has_next = S.next(ui + 1, nxt);
        const char* nA = has_next ? (const char*)g.A + (size_t)nxt.pm * tstepA : cA; const char* nB = has_next ? (const char*)g.Bt + (size_t)nxt.pn * tstep : cB;
        for (int t = 0; t < nt; t += 2) {
            const bool last = (t == nt - 2);
            const char* a1 = cA + (size_t)(t + 1) * kstep;
            const char* a2 = last ? nA : cA + (size_t)(t + 2) * kstep; const char* b2 = last ? nB : cB + (size_t)(t + 2) * kstep;
            const char* a3 = a2 + kstep; const char* b3 = b2 + kstep;
            if (last && has_next) S.a_ready(nxt);
            if constexpr (SP2) {
            PG8_LDB(B0, 0, 0); PG8_LDB(B1, 0, 1); PG8_SCHED; PG8_LDA(At, 0, 0); PG8_STAGE(PG8_SA(1, 1), a1 + hstepA, voffA);
            PG8_WAIT_V(8); PG8_WAIT_L(0); PG8_BAR; PG8_MMA(0, 0, At, B0); PG8_MMA(0, 1, At, B1); PG8_BAR; PG8_SCHED;
            PG8_LDA(At, 0, 1); PG8_STAGE(PG8_SB(0, 0), b2, voffB); PG8_STAGE(PG8_SB(0, 1), b2 + hstep, voffB); PG8_STAGE(PG8_SA(0, 0), a2, voffA);
            PG8_WAIT_V(8); PG8_WAIT_L(0); PG8_BAR; PG8_MMA(1, 0, At, B0); PG8_MMA(1, 1, At, B1); PG8_BAR; PG8_SCHED;
            PG8_LDB(B0, 1, 0); PG8_LDB(B1, 1, 1); PG8_SCHED; PG8_LDA(At, 1, 0); PG8_STAGE(PG8_SA(0, 1), a2 + hstepA, voffA);
            PG8_WAIT_V(8); PG8_WAIT_L(0); PG8_BAR; PG8_MMA(0, 0, At, B0); PG8_MMA(0, 1, At, B1); PG8_BAR; PG8_SCHED;
            PG8_LDA(At, 1, 1); PG8_STAGE(PG8_SB(1, 0), b3, voffB); PG8_STAGE(PG8_SB(1, 1), b3 + hstep, voffB); PG8_STAGE(PG8_SA(1, 0), a3, voffA);
            PG8_WAIT_V(8); PG8_WAIT_L(0); PG8_BAR; PG8_MMA(1, 0, At, B0); PG8_MMA(1, 1, At, B1); PG8_BAR; PG8_SCHED;
            } else {
            PG8_LDB(B0, 0, 0); PG8_SCHED; PG8_LDA(At, 0, 0); PG8_STAGE(PG8_SA(1, 1), a1 + hstepA, voffA);
            PG8_WAIT_L(8); PG8_BAR; PG8_WAIT_L(0); PG8_MMA(0, 0, At, B0); PG8_BAR; PG8_SCHED;
            PG8_LDB(B1, 0, 1); PG8_STAGE(PG8_SB(0, 0), b2, voffB);
            PG8_BAR; PG8_WAIT_L(0); PG8_MMA(0, 1, At, B1); PG8_BAR;
            PG8_LDA(At, 0, 1); PG8_STAGE(PG8_SA(0, 0), a2, voffA);
            PG8_BAR; PG8_WAIT_L(0); PG8_MMA(1, 0, At, B0); PG8_BAR; PG8_SCHED;
            PG8_STAGE(PG8_SB(0, 1), b2 + hstep, voffB);
            PG8_WAIT_V(6); PG8_BAR; PG8_MMA(1, 1, At, B1); PG8_BAR;
            PG8_LDB(B0, 1, 0); PG8_SCHED; PG8_LDA(At, 1, 0); PG8_STAGE(PG8_SA(0, 1), a2 + hstepA, voffA);
            PG8_WAIT_L(8); PG8_BAR; PG8_WAIT_L(0); PG8_MMA(0, 0, At, B0); PG8_BAR; PG8_SCHED;
            PG8_LDB(B1, 1, 1); PG8_STAGE(PG8_SB(1, 0), b3, voffB);
            PG8_BAR; PG8_WAIT_L(0); PG8_MMA(0, 1, At, B1); PG8_BAR;
            PG8_LDA(At, 1, 1); PG8_STAGE(PG8_SA(1, 0), a3, voffA);
            PG8_BAR; PG8_WAIT_L(0); PG8_MMA(1, 0, At, B0); PG8_BAR; PG8_SCHED;
            PG8_STAGE(PG8_SB(1, 1), b3 + hstep, voffB);
            PG8_WAIT_V(6); PG8_BAR; PG8_MMA(1, 1, At, B1); PG8_BAR;
            }
        }
        if constexpr (ALIGN_EPI) { if (wr == 0) PG8_BAR; }
        if constexpr (!Epi::AFTER_DRAIN) { E(acc, cur, wr, wc, fr, fq); S.done(cur); }
        if (!has_next) break;
#pragma unroll
        for (int a = 0; a < 2; ++a)
#pragma unroll
            for (int b = 0; b < 2; ++b)
#pragma unroll
                for (int m = 0; m < 4; ++m)
#pragma unroll
                    for (int n = 0; n < 2; ++n) acc[a][b][m][n] = (f32x4){0.f, 0.f, 0.f, 0.f};
        cur = nxt; cA = nA; cB = nB; ++ui;
        if constexpr (ALIGN_EPI) { if (wr == 1) PG8_BAR; }
    }
    PG8_WAIT_V(0);
    if constexpr (!ALIGN_EPI) { if (wr == 0) PG8_BAR; }
    PG8_BAR;
    if constexpr (Epi::AFTER_DRAIN) { E.fused(acc, cur, wr, wc, fr, fq, lds, wid, lane); S.done(cur); }
#undef PG8_SA
#undef PG8_SB
#undef PG8_STAGE
#undef PG8_LDA
#undef PG8_LDB
#undef PG8_MMA
#undef PG8_WAIT_V
#undef PG8_WAIT_L
#undef PG8_BAR
#undef PG8_SCHED
}
}

#define LAS __attribute__((address_space(3)))
typedef unsigned short bf16;
typedef short bf16x8 __attribute__((ext_vector_type(8)));
typedef short v4i16_t __attribute__((ext_vector_type(4)));
typedef float f32x4 __attribute__((ext_vector_type(4)));
typedef float f32x2 __attribute__((ext_vector_type(2)));
typedef float f32x16 __attribute__((ext_vector_type(16)));
typedef unsigned u32x4 __attribute__((ext_vector_type(4)));
typedef unsigned u32x2 __attribute__((ext_vector_type(2)));

constexpr int T = 98304, TP = 32768, DM = 1024, FF = 2816, NIN = 3584, SEQ = 2048, NB = 48;
constexpr float EPS = 1e-6f, LOG2E = 1.4426950408889634f;
constexpr float C2 = 0.125f * LOG2E;
constexpr size_t MiB = 1u << 20;
constexpr size_t WS_STAT = 8 * MiB  , WS_ROT = 4 * MiB, WS_W = 16 * MiB, W_LAYER = 42 * MiB, WS_HB = 104 * MiB, WS_P = 296 * MiB, WS_END = 968 * MiB;
constexpr size_t WO_GU1 = 0, WO_D1 = 11534336, WO_IN = WO_D1 + 5767168, WO_OUT = WO_IN + 7340032, WO_GU2 = WO_OUT + 2097152, WO_D2 = WO_GU2 + 11534336;
static_assert(WO_D2 + 5767168 == W_LAYER, "weight map");
constexpr int LDS_BYTES = 147456;
constexpr int LDS_TAB = 131072, LDS_MISC = 139264, LDS_STATS = 131072, LDS_BARW = 143360;
constexpr size_t WS_BAR = 5 * MiB, WS_BAR_BYTES = 16384;
constexpr int NPHASE = 21;

typedef unsigned long long u64;
__device__ __forceinline__ float ss_scale(const u64* ss, int row) { return __builtin_amdgcn_rsqf((float)ss[row] * (1.f / 4294967296.f / 1024.f) + EPS); }
__device__ __forceinline__ u64 ss_fix(float q) { return (u64)(q * 4294967296.f); }
struct Args { const float* in[21]; float* out; unsigned char* ws; int lo, hi, dry, pad; };

#define LDS_WAIT() asm volatile("s_waitcnt lgkmcnt(0)" ::: "memory")

__device__ __forceinline__ unsigned pkbf(float lo, float hi) { typedef __bf16 bf2_t __attribute__((ext_vector_type(2))); f32x2 v = {lo, hi}; bf2_t b = __builtin_convertvector(v, bf2_t); return __builtin_bit_cast(unsigned, b); }
__device__ __forceinline__ float bflo(unsigned u) { return __builtin_bit_cast(float, u << 16); }
__device__ __forceinline__ float bfhi(unsigned u) { return __builtin_bit_cast(float, u & 0xffff0000u); }
__device__ __forceinline__ float wave_sum(float v) {
#pragma unroll
    for (int o = 1; o < 64; o <<= 1) v += __shfl_xor(v, o);
    return v;
}
__device__ __forceinline__ float wave_max(float v) {
#pragma unroll
    for (int o = 1; o < 64; o <<= 1) v = fmaxf(v, __shfl_xor(v, o));
    return v;
}
__device__ __forceinline__ float silu_f(float g) { return g * __builtin_amdgcn_rcpf(1.f + __builtin_amdgcn_exp2f(-g * LOG2E)); }
__device__ __forceinline__ int crow(int r, int hi) { return (r & 3) + 8 * (r >> 2) + 4 * hi; }
__device__ __forceinline__ unsigned offb(unsigned row, unsigned ch) { return 256u * row + 16u * (ch ^ (((row & 3u) << 2) | ((row >> 2) & 3u))); }
__device__ __forceinline__ unsigned tr_base_perm(int c, int tt, int lane) {
    const unsigned hi = lane >> 5, g1 = (lane >> 4) & 1, q4 = (lane & 15) >> 2, p4 = lane & 3, lowc = 2 * g1 + (p4 >> 1);
    return 1024u * hi + 256u * q4 + 8u * (p4 & 1) + 64u * ((unsigned)c ^ q4) + 16u * ((lowc ^ hi) ^ (2u * tt));
}
__device__ __forceinline__ unsigned tr_base_nat(int c, int tt, int lane) {
    const unsigned hi = lane >> 5, g1 = (lane >> 4) & 1, q4 = (lane & 15) >> 2, p4 = lane & 3, lowc = 2 * g1 + (p4 >> 1);
    return 2048u * hi + 256u * q4 + 8u * (p4 & 1) + 64u * ((unsigned)c ^ q4) + 16u * ((lowc ^ (2u * hi)) ^ (unsigned)tt);
}
__device__ __forceinline__ unsigned row_base(int cK, int lane) {
    const unsigned r32 = lane & 31, hi = lane >> 5, xk = ((r32 & 3u) << 2) | ((r32 >> 2) & 3u);
    return 256u * r32 + 16u * (((unsigned)cK + hi) ^ xk);
}
__device__ __forceinline__ bf16x8 tr_pair(const LAS unsigned char* p0, const LAS unsigned char* p1) {
    const v4i16_t lo = __builtin_amdgcn_ds_read_tr16_b64_v4i16((LAS v4i16_t*)p0);
    const v4i16_t hi = __builtin_amdgcn_ds_read_tr16_b64_v4i16((LAS v4i16_t*)p1);
    return (bf16x8){lo[0], lo[1], lo[2], lo[3], hi[0], hi[1], hi[2], hi[3]};
}
__device__ __forceinline__ bf16x8 pack8(const f32x16& S, int s) {
    u32x4 w; w.x = pkbf(S[8 * s + 0], S[8 * s + 1]); w.y = pkbf(S[8 * s + 2], S[8 * s + 3]); w.z = pkbf(S[8 * s + 4], S[8 * s + 5]); w.w = pkbf(S[8 * s + 6], S[8 * s + 7]);
    return __builtin_bit_cast(bf16x8, w);
}
__device__ __forceinline__ int rel_bucket(int rel) {
    const int n = rel < 0 ? -rel : rel; int b;
    if (n < 8) b = n; else if (n < 12) b = 8; else if (n < 16) b = 9; else if (n < 23) b = 10; else if (n < 32) b = 11; else if (n < 46) b = 12; else if (n < 64) b = 13; else if (n < 91) b = 14; else b = 15;
    return b + (rel > 0 ? 16 : 0);
}

template <bool NN> struct EpiSwiGLU {
    static constexpr bool PERM = true, AFTER_DRAIN = false;
    bf16* O; const u64* ss; const u64* ssw;
    __device__ __forceinline__ void operator()(const f32x4 (&acc)[2][2][4][2], const pg8::Unit& u, int wr, int wc, int fr, int fq) const {
        const int row0 = u.pm * 256 + wr * 64 + fr, col0 = u.pn * 128 + wc * 32 + 8 * fq;
#pragma unroll
        for (int ai = 0; ai < 2; ++ai)
#pragma unroll
            for (int m = 0; m < 4; ++m) {
                const int row = row0 + ai * 128 + m * 16;
                float s = ss_scale(ss, row);
                if constexpr (NN) s *= __builtin_amdgcn_rsqf(s * s * (float)ssw[row] * (1.f / 4294967296.f / 1024.f) + EPS);
                float a[8];
#pragma unroll
                for (int n = 0; n < 2; ++n)
#pragma unroll
                    for (int i = 0; i < 4; ++i) { const float g = acc[ai][0][m][n][i] * s, uu = acc[ai][1][m][n][i] * s; a[4 * n + i] = silu_f(g) * uu; }
                u32x4 w; w.x = pkbf(a[0], a[1]); w.y = pkbf(a[2], a[3]); w.z = pkbf(a[4], a[5]); w.w = pkbf(a[6], a[7]);
                *(u32x4*)(O + (size_t)row * FF + col0) = w;
            }
    }
};
template <int MODE, bool WF32> struct EpiRes {
    static constexpr bool PERM = true, AFTER_DRAIN = false;
    float* out; bf16* hb; u64* ssn; int dry; const float* gf; const u64* rss; u64* ssw;
    __device__ __forceinline__ void operator()(const f32x4 (&acc)[2][2][4][2], const pg8::Unit& u, int wr, int wc, int fr, int fq) const {
        if (dry) return;
        const int row0 = u.pm * 256 + wr * 64 + fr, col0 = u.pn * 256 + wc * 32 + 8 * fq;
        f32x4 g0[2], g1[2];
        if constexpr (MODE != 0) {
#pragma unroll
            for (int bj = 0; bj < 2; ++bj) { g0[bj] = *(const f32x4*)(gf + col0 + bj * 128); g1[bj] = *(const f32x4*)(gf + col0 + bj * 128 + 4); if constexpr (MODE == 1) { g0[bj] = g0[bj] * g0[bj]; g1[bj] = g1[bj] * g1[bj]; } }
        }
#pragma unroll
        for (int ai = 0; ai < 2; ++ai)
#pragma unroll
            for (int m = 0; m < 4; ++m) {
                const int row = row0 + ai * 128 + m * 16;
                float q = 0.f, qw = 0.f, sh = 1.f;
                if constexpr (MODE == 2) sh = ss_scale(rss, row);
#pragma unroll
                for (int bj = 0; bj < 2; ++bj) {
                    const int c = col0 + bj * 128;
                    const u32x4 rb = *(const u32x4*)(hb + (size_t)row * DM + c);
                    f32x4 r0 = {bflo(rb.x), bfhi(rb.x), bflo(rb.y), bfhi(rb.y)}, r1 = {bflo(rb.z), bfhi(rb.z), bflo(rb.w), bfhi(rb.w)};
                    if constexpr (MODE == 2) { r0 = r0 * sh * g0[bj]; r1 = r1 * sh * g1[bj]; }
                    const f32x4 v0 = r0 + acc[ai][bj][m][0], v1 = r1 + acc[ai][bj][m][1];
                    if constexpr (WF32) { *(f32x4*)(out + (size_t)row * DM + c) = v0; *(f32x4*)(out + (size_t)row * DM + c + 4) = v1; }
                    u32x4 w; w.x = pkbf(v0[0], v0[1]); w.y = pkbf(v0[2], v0[3]); w.z = pkbf(v1[0], v1[1]); w.w = pkbf(v1[2], v1[3]);
                    *(u32x4*)(hb + (size_t)row * DM + c) = w;
                    const f32x4 s0 = v0 * v0, s1 = v1 * v1;
                    q += (s0[0] + s0[1]) + (s0[2] + s0[3]) + (s1[0] + s1[1]) + (s1[2] + s1[3]);
                    if constexpr (MODE == 1) { const f32x4 t0 = s0 * g0[bj], t1 = s1 * g1[bj]; qw += (t0[0] + t0[1]) + (t0[2] + t0[3]) + (t1[0] + t1[1]) + (t1[2] + t1[3]); }
                }
                q += __shfl_xor(q, 16); q += __shfl_xor(q, 32);
                if constexpr (MODE == 1) { qw += __shfl_xor(qw, 16); qw += __shfl_xor(qw, 32); }
                if (fq == 0) {
                    __hip_atomic_fetch_add(ssn + row, ss_fix(q), __ATOMIC_RELAXED, __HIP_MEMORY_SCOPE_AGENT);
                    if constexpr (MODE == 1) __hip_atomic_fetch_add(ssw + row, ss_fix(qw), __ATOMIC_RELAXED, __HIP_MEMORY_SCOPE_AGENT);
                }
            }
    }
};
struct EpiWin {
    static constexpr bool PERM = true, AFTER_DRAIN = false;
    bf16* P; const u64* ss; const f32x2* rot; const float* qg; const float* kg;
    __device__ __forceinline__ void operator()(const f32x4 (&acc)[2][2][4][2], const pg8::Unit& u, int wr, int wc, int fr, int fq) const {
        const int type = u.pn >> 1;
        const int row0 = u.pm * 256 + wr * 64 + fr, cbase = u.pn * 256;
        if (type <= 1) {
            const int hh = wc >> 1, j0 = 32 * (wc & 1) + 8 * fq;
#pragma unroll
            for (int ai = 0; ai < 2; ++ai)
#pragma unroll
                for (int m = 0; m < 4; ++m) {
                    const int row = row0 + ai * 128 + m * 16;
                    const float s = ss_scale(ss, row);
                    const f32x4* rp = (const f32x4*)(rot + (size_t)(row & (SEQ - 1)) * 64 + j0);
                    float o1[8], o2[8];
#pragma unroll
                    for (int n = 0; n < 2; ++n) {
                        const f32x4 cs0 = rp[2 * n], cs1 = rp[2 * n + 1];
                        const float cc[4] = {cs0[0], cs0[2], cs1[0], cs1[2]}, sn[4] = {cs0[1], cs0[3], cs1[1], cs1[3]};
#pragma unroll
                        for (int i = 0; i < 4; ++i) { const float x1 = acc[ai][0][m][n][i] * s, x2 = acc[ai][1][m][n][i] * s; o1[4 * n + i] = x1 * cc[i] - x2 * sn[i]; o2[4 * n + i] = x1 * sn[i] + x2 * cc[i]; }
                    }
                    bf16* op = P + (size_t)row * NIN + cbase + hh * 128 + j0;
                    u32x4 w; w.x = pkbf(o1[0], o1[1]); w.y = pkbf(o1[2], o1[3]); w.z = pkbf(o1[4], o1[5]); w.w = pkbf(o1[6], o1[7]); *(u32x4*)op = w;
                    w.x = pkbf(o2[0], o2[1]); w.y = pkbf(o2[2], o2[3]); w.z = pkbf(o2[4], o2[5]); w.w = pkbf(o2[6], o2[7]); *(u32x4*)(op + 64) = w;
                }
        } else if (type == 4 || type == 5) {
            const int hh = wc >> 1, t = wc & 1; const float* gp = (type == 4 ? qg : kg) + t * 64 + 8 * fq; const float mul = (type == 4) ? C2 : 1.f;
            float gv[2][8];
#pragma unroll
            for (int bj = 0; bj < 2; ++bj)
#pragma unroll
                for (int i = 0; i < 8; ++i) gv[bj][i] = gp[bj * 32 + i] * mul;
#pragma unroll
            for (int ai = 0; ai < 2; ++ai)
#pragma unroll
                for (int m = 0; m < 4; ++m) {
                    const int row = row0 + ai * 128 + m * 16;
                    const float s = ss_scale(ss, row);
                    float v[2][8]; float q = 0.f;
#pragma unroll
                    for (int bj = 0; bj < 2; ++bj)
#pragma unroll
                        for (int n = 0; n < 2; ++n)
#pragma unroll
                            for (int i = 0; i < 4; ++i) { const float x = acc[ai][bj][m][n][i] * s; v[bj][4 * n + i] = x; q += x * x; }
                    q += __shfl_xor(q, 16); q += __shfl_xor(q, 32);
                    const float rs = __builtin_amdgcn_rsqf(q * (1.f / 64.f) + EPS);
                    bf16* op = P + (size_t)row * NIN + cbase + hh * 128 + t * 64 + 8 * fq;
#pragma unroll
                    for (int bj = 0; bj < 2; ++bj) {
                        u32x4 w; w.x = pkbf(v[bj][0] * rs * gv[bj][0], v[bj][1] * rs * gv[bj][1]); w.y = pkbf(v[bj][2] * rs * gv[bj][2], v[bj][3] * rs * gv[bj][3]);
                        w.z = pkbf(v[bj][4] * rs * gv[bj][4], v[bj][5] * rs * gv[bj][5]); w.w = pkbf(v[bj][6] * rs * gv[bj][6], v[bj][7] * rs * gv[bj][7]);
                        *(u32x4*)(op + bj * 32) = w;
                    }
                }
        } else {
            const bool act = (type == 3);
#pragma unroll
            for (int ai = 0; ai < 2; ++ai)
#pragma unroll
                for (int m = 0; m < 4; ++m) {
                    const int row = row0 + ai * 128 + m * 16;
                    const float s = ss_scale(ss, row);
                    bf16* op = P + (size_t)row * NIN + cbase + wc * 32 + 8 * fq;
#pragma unroll
                    for (int bj = 0; bj < 2; ++bj) {
                        float v[8];
#pragma unroll
                        for (int n = 0; n < 2; ++n)
#pragma unroll
                            for (int i = 0; i < 4; ++i) { const float x = acc[ai][bj][m][n][i] * s; v[4 * n + i] = act ? silu_f(x) : x; }
                        u32x4 w; w.x = pkbf(v[0], v[1]); w.y = pkbf(v[2], v[3]); w.z = pkbf(v[4], v[5]); w.w = pkbf(v[6], v[7]);
                        *(u32x4*)(op + bj * 128) = w;
                    }
                }
        }
    }
};

__device__ __forceinline__ void tr_item(const float* W, int ldw, int K, int k0, int srccol0, bf16* WT, int dstrow0, const float* gain, float scale, LAS float* scr, int lane, const float* gain2 = nullptr) {
#pragma unroll
    for (int i = 0; i < 32; ++i) { const int kk = 2 * i + (lane >> 5); float gsc = gain ? gain[k0 + kk] * scale : scale; if (gain2) gsc *= gain2[k0 + kk]; scr[kk * 33 + (lane & 31)] = W[(size_t)(k0 + kk) * ldw + srccol0 + (lane & 31)] * gsc; }
    LDS_WAIT();
    const int c = lane & 7;
#pragma unroll
    for (int j = 0; j < 4; ++j) { const int n = (lane >> 3) + 8 * j; const LAS float* s = scr + (8 * c) * 33 + n;
        u32x4 o; o.x = pkbf(s[0 * 33], s[1 * 33]); o.y = pkbf(s[2 * 33], s[3 * 33]); o.z = pkbf(s[4 * 33], s[5 * 33]); o.w = pkbf(s[6 * 33], s[7 * 33]);
        *(u32x4*)(WT + (size_t)(dstrow0 + n) * K + k0 + 8 * c) = o; }
    LDS_WAIT();
}
__device__ __forceinline__ void phase_prep(const Args& a, unsigned char* ws, LAS unsigned char* lds, int vcu, int G, int tid, int wid, int lane) {
    LAS float* scr = (LAS float*)(lds + wid * 16384);
    const int gw = vcu * 8 + wid, NGW = G * 8;
    constexpr int I_GU = 16 * 176, I_D = 44 * 32, I_IN = 16 * 112, I_OUT = 16 * 32, I_L = 2 * I_GU + 2 * I_D + I_IN + I_OUT;
    for (int it = gw; it < 2 * I_L; it += NGW) {
        const int l = it / I_L; int r = it % I_L;
        unsigned char* wl = ws + WS_W + (size_t)l * W_LAYER;
        if (r < I_GU || (r >= I_GU + I_D + I_IN + I_OUT && r < 2 * I_GU + I_D + I_IN + I_OUT)) {
            const bool second = r >= I_GU; if (second) r -= I_GU + I_D + I_IN + I_OUT;
            const int kb = r / 176, nb = r % 176, n0 = nb * 32, pn = n0 >> 8, half = (n0 >> 7) & 1, j0 = n0 & 127;
            const float* src = a.in[second ? (half ? 18 : 17) : (half ? 4 : 3)] + (size_t)l * DM * FF;
            tr_item(src, FF, DM, kb * 64, pn * 128 + j0, (bf16*)(wl + (second ? WO_GU2 : WO_GU1)), n0, a.in[second ? 16 : 2] + l * DM, 1.f, scr, lane, (!second && l > 0) ? a.in[20] + (l - 1) * DM : nullptr);
            continue;
        }
        r -= I_GU;
        if (r < I_D) { const int kb = r / 32, nb = r % 32; tr_item(a.in[5] + (size_t)l * FF * DM, DM, FF, kb * 64, nb * 32, (bf16*)(wl + WO_D1), nb * 32, nullptr, 0.5f, scr, lane); continue; }
        r -= I_D;
        if (r < I_IN) {
            const int kb = r / 112, nb = r % 112, n0 = nb * 32, pn = n0 >> 8, w = n0 & 255, bj = w >> 7, q0 = w & 127, type = pn >> 1;
            int src;
            if (type <= 1) src = pn * 256 + (q0 >> 6) * 128 + bj * 64 + (q0 & 63);
            else if (type == 4 || type == 5) { const int wc = q0 >> 5; src = pn * 256 + (wc >> 1) * 128 + (wc & 1) * 64 + bj * 32; }
            else src = n0;
            tr_item(a.in[7] + (size_t)l * DM * NIN, NIN, DM, kb * 64, src, (bf16*)(wl + WO_IN), n0, a.in[6] + l * DM, type == 1 ? 0.08838834764831845f : 1.f, scr, lane);
            continue;
        }
        r -= I_IN;
        if (r < I_OUT) { const int kb = r / 32, nb = r % 32; tr_item(a.in[15] + (size_t)l * DM * DM, DM, DM, kb * 64, nb * 32, (bf16*)(wl + WO_OUT), nb * 32, nullptr, 1.f, scr, lane); continue; }
        r -= I_OUT + I_GU;
        { const int kb = r / 32, nb = r % 32; tr_item(a.in[19] + (size_t)l * FF * DM, DM, FF, kb * 64, nb * 32, (bf16*)(wl + WO_D2), nb * 32, nullptr, 0.5f, scr, lane); }
    }
    u64* stat = (u64*)(ws + WS_STAT); bf16* hb = (bf16*)(ws + WS_HB);
    for (int row0 = gw; row0 < T; row0 += 4 * NGW) {
        f32x4 v[4][4]; float sq[4];
#pragma unroll
        for (int k = 0; k < 4; ++k) {
            const int row = row0 + k * NGW;
            if (row < T) {
                const float* xr = (row < TP) ? a.in[0] + (size_t)row * DM : a.in[1] + (size_t)(row - TP) * DM;
#pragma unroll
                for (int j = 0; j < 4; ++j) v[k][j] = ((const f32x4*)xr)[lane + 64 * j];
            }
        }
#pragma unroll
        for (int k = 0; k < 4; ++k) {
            const int row = row0 + k * NGW;
            if (row < T) {
                float s = 0.f;
#pragma unroll
                for (int j = 0; j < 4; ++j) s += (v[k][j][0] * v[k][j][0] + v[k][j][1] * v[k][j][1]) + (v[k][j][2] * v[k][j][2] + v[k][j][3] * v[k][j][3]);
                sq[k] = wave_sum(s);
                if (lane == 0) stat[row] = ss_fix(sq[k]);
#pragma unroll
                for (int j = 0; j < 4; ++j) { u32x2 w; w.x = pkbf(v[k][j][0], v[k][j][1]); w.y = pkbf(v[k][j][2], v[k][j][3]); *(u32x2*)(hb + (size_t)row * DM + 4 * (lane + 64 * j)) = w; }
            }
        }
    }
    const int gt = vcu * 512 + tid, NT = G * 512;
    for (int i = gt; i < T; i += NT) { stat[1 * T + i] = 0; stat[2 * T + i] = 0; stat[3 * T + i] = 0; stat[4 * T + i] = 0; stat[5 * T + i] = 0; stat[6 * T + i] = 0; stat[7 * T + i] = 0; }
    f32x2* rot = (f32x2*)(ws + WS_ROT);
    for (int i = gt; i < SEQ * 64; i += NT) {
        const int pos = i >> 6, j = i & 63;
        const float inv = exp2f((float)(-j) * 0.20762050593046015f);
        const float ang = (float)pos * inv;
        const float fr = fmaf(ang, 0.15915494309189535f, -rintf(ang * 0.15915494309189535f));
        rot[i] = (f32x2){__builtin_amdgcn_cosf(fr), __builtin_amdgcn_sinf(fr)};
    }
}

__device__ __forceinline__ void phase_fnorm(const Args& a, unsigned char* ws, float* outp, int l, int vcu, int G, int wid, int lane) {
    const int gw = vcu * 8 + wid, NGW = G * 8;
    u64* stat = (u64*)(ws + WS_STAT); bf16* hb = (bf16*)(ws + WS_HB);
    const f32x4* gp = (const f32x4*)(a.in[20] + l * DM);
    f32x4 g[4];
#pragma unroll
    for (int j = 0; j < 4; ++j) g[j] = gp[lane + 64 * j];
    for (int row0 = gw; row0 < T; row0 += 2 * NGW) {
        f32x4 v[2][4]; float sc[2];
#pragma unroll
        for (int k = 0; k < 2; ++k) {
            const int row = row0 + k * NGW;
            if (row < T) {
                const bf16* hr = hb + (size_t)row * DM;
#pragma unroll
                for (int j = 0; j < 4; ++j) { const u32x2 w = *(const u32x2*)(hr + 4 * (lane + 64 * j)); v[k][j] = (f32x4){bflo(w.x), bfhi(w.x), bflo(w.y), bfhi(w.y)}; }
                sc[k] = ss_scale(stat + (size_t)(l * 4 + 3) * T, row);
            }
        }
#pragma unroll
        for (int k = 0; k < 2; ++k) {
            const int row = row0 + k * NGW;
            if (row < T) {
                float* hr = outp + (size_t)row * DM; float q = 0.f;
#pragma unroll
                for (int j = 0; j < 4; ++j) {
                    const f32x4 x = v[k][j] * sc[k] * g[j];
                    ((f32x4*)hr)[lane + 64 * j] = x; q += (x[0] * x[0] + x[1] * x[1]) + (x[2] * x[2] + x[3] * x[3]);
                    if (l == 0) { u32x2 w; w.x = pkbf(x[0], x[1]); w.y = pkbf(x[2], x[3]); *(u32x2*)(hb + (size_t)row * DM + 4 * (lane + 64 * j)) = w; }
                }
                if (l == 0) { q = wave_sum(q); if (lane == 0) stat[4 * T + row] = ss_fix(q); }
            }
        }
    }
}

__device__ __forceinline__ void ret_gammas(const Args& a, int l, int h, float& lgf2, float& lgb2) {
    const float xf = a.in[8][(l * 2 + 0) * 4 + h], xb = a.in[8][(l * 2 + 1) * 4 + h];
    lgf2 = -log1pf(expf(-xf)) * LOG2E; lgb2 = -log1pf(expf(-xb)) * LOG2E;
}
__device__ __forceinline__ void r1_unit(const Args& a, unsigned char* ws, bf16* STB, LAS unsigned char* lds, int l, int unit, int tid, int wid, int lane) {
    asm volatile("" : "+v"(lane), "+v"(tid));
    const int n = unit & 15, h = (unit >> 4) & 3, b = unit >> 6;
    float lgf2, lgb2; ret_gammas(a, l, h, lgf2, lgb2);
    const bf16* P = (const bf16*)(ws + WS_P);
    const bf16* kp = P + (size_t)(b * SEQ + n * 128) * NIN + 512 + h * 128;
    LAS unsigned char* KF = lds, * KB = lds + 32768, * VT = lds + 65536;
#pragma unroll
    for (int i = 0; i < 4; ++i) {
        const int c = tid + 512 * i, row = c >> 4, ch = c & 15;
        const u32x4 kv = *(const u32x4*)(kp + (size_t)row * NIN + ch * 8), vv = *(const u32x4*)(kp + 512 + (size_t)row * NIN + ch * 8);
        const float zf = __builtin_amdgcn_exp2f((float)(127 - row) * lgf2), zb = __builtin_amdgcn_exp2f((float)row * lgb2);
        u32x4 wf, wb;
#pragma unroll
        for (int e = 0; e < 4; ++e) { const float x0 = bflo(kv[e]), x1 = bfhi(kv[e]); wf[e] = pkbf(x0 * zf, x1 * zf); wb[e] = pkbf(x0 * zb, x1 * zb); }
        const unsigned o = offb(row, ch);
        *(LAS u32x4*)(KF + o) = wf; *(LAS u32x4*)(KB + o) = wb; *(LAS u32x4*)(VT + o) = vv;
    }
    __syncthreads();
    const int r32 = lane & 31, hi = lane >> 5, g1 = (lane >> 4) & 1, q4 = (lane & 15) >> 2, p4 = lane & 3;
    const int dir = wid >> 2, db = wid & 3;
    const LAS unsigned char* KS = dir ? KB : KF;
    f32x16 acc[4];
#pragma unroll
    for (int eb = 0; eb < 4; ++eb)
#pragma unroll
        for (int r = 0; r < 16; ++r) acc[eb][r] = 0.f;
    unsigned vbn[4][2];
#pragma unroll
    for (int c = 0; c < 4; ++c) { vbn[c][0] = tr_base_nat(c, 0, lane); vbn[c][1] = tr_base_nat(c, 1, lane); }
    const unsigned kb0 = tr_base_nat(db, 0, lane), kb1 = tr_base_nat(db, 1, lane);
#pragma unroll
    for (int ks = 0; ks < 8; ++ks) {
        const bf16x8 bfr = tr_pair(KS + kb0 + 256 * (16 * ks), KS + kb1 + 256 * (16 * ks + 4));
#pragma unroll
        for (int eb = 0; eb < 4; ++eb) { const bf16x8 afr = tr_pair(VT + vbn[eb][0] + 256 * (16 * ks), VT + vbn[eb][1] + 256 * (16 * ks + 4)); acc[eb] = __builtin_amdgcn_mfma_f32_32x32x16_bf16(afr, bfr, acc[eb], 0, 0, 0); }
    }
    bf16* st = STB + ((size_t)(((b * 4 + h) * 16 + n) * 2 + dir)) * 16384 + (size_t)(32 * db + r32) * 128;
#pragma unroll
    for (int eb = 0; eb < 4; ++eb)
#pragma unroll
        for (int pr = 0; pr < 2; ++pr) {
            const unsigned ax = pkbf(acc[eb][8 * pr], acc[eb][8 * pr + 1]), ay = pkbf(acc[eb][8 * pr + 2], acc[eb][8 * pr + 3]), bx = pkbf(acc[eb][8 * pr + 4], acc[eb][8 * pr + 5]), by = pkbf(acc[eb][8 * pr + 6], acc[eb][8 * pr + 7]);
            const auto sx = __builtin_amdgcn_permlane32_swap(ax, bx, false, false), sy = __builtin_amdgcn_permlane32_swap(ay, by, false, false);
            u32x4 w; w.x = sx[0]; w.y = sy[0]; w.z = sx[1]; w.w = sy[1];
            *(u32x4*)(st + 32 * eb + 16 * pr + 8 * hi) = w; }
    __syncthreads();
}
__device__ __forceinline__ void phase_scan(const Args& a, unsigned char* ws, bf16* STB, int l, int vcu, int G, int tid, int z) {
    bf16* ST = STB;
    const int gt = vcu * 512 + tid, NT = G * 512;
    for (int it = gt; it < 192 * 2 * 2048; it += NT) {
        const int grp = it & 2047, dir = (it >> 11) & 1, bh = it >> 12, h = bh & 3;
        float lgf2, lgb2; ret_gammas(a, l, h, lgf2, lgb2);
        const float g = __builtin_amdgcn_exp2f(128.f * (dir ? lgb2 : lgf2));
        bf16* base = ST + ((size_t)(bh * 16) * 2 + dir) * 16384 + grp * 8;
        u32x4 kv[16];
        const size_t cst = (size_t)(32768 + z);
#pragma unroll
        for (int n = 0; n < 16; ++n) kv[n] = *(const u32x4*)(base + (size_t)n * cst);
        float c[8];
#pragma unroll
        for (int e = 0; e < 8; ++e) c[e] = 0.f;
#pragma unroll
        for (int i = 0; i < 16; ++i) {
            const int n = dir ? 15 - i : i;
            u32x4 w; w.x = pkbf(c[0], c[1]); w.y = pkbf(c[2], c[3]); w.z = pkbf(c[4], c[5]); w.w = pkbf(c[6], c[7]);
            *(u32x4*)(base + (size_t)n * cst) = w;
#pragma unroll
            for (int e = 0; e < 4; ++e) { c[2 * e] = bflo(kv[n][e]) + g * c[2 * e]; c[2 * e + 1] = bfhi(kv[n][e]) + g * c[2 * e + 1]; }
        }
    }
}
__device__ __forceinline__ void r2_unit(const Args& a, unsigned char* ws, bf16* STB, LAS unsigned char* lds, int l, int unit, int tid, int wid, int lane, int dry) {
    asm volatile("" : "+v"(lane), "+v"(tid));
    const int n = unit & 15, h = (unit >> 4) & 3, b = unit >> 6;
    float lgf2, lgb2; ret_gammas(a, l, h, lgf2, lgb2);
    bf16* P = (bf16*)(ws + WS_P);
    const bf16* kp = P + (size_t)(b * SEQ + n * 128) * NIN + 512 + h * 128;
    const bf16* sp = STB + ((size_t)((b * 4 + h) * 16 + n) * 2) * 16384;
    LAS unsigned char* KT = lds, * VT = lds + 32768, * SF = lds + 65536, * SB = lds + 98304;
#pragma unroll
    for (int i = 0; i < 4; ++i) {
        const int c = tid + 512 * i, row = c >> 4, ch = c & 15; const unsigned o = offb(row, ch);
        const u32x4 kv = *(const u32x4*)(kp + (size_t)row * NIN + ch * 8), vv = *(const u32x4*)(kp + 512 + (size_t)row * NIN + ch * 8);
        const u32x4 sf = *(const u32x4*)(sp + row * 128 + ch * 8), sb = *(const u32x4*)(sp + 16384 + row * 128 + ch * 8);
        *(LAS u32x4*)(KT + o) = kv; *(LAS u32x4*)(VT + o) = vv; *(LAS u32x4*)(SF + o) = sf; *(LAS u32x4*)(SB + o) = sb;
    }
    const int r32 = lane & 31, hi = lane >> 5, g1 = (lane >> 4) & 1, q4 = (lane & 15) >> 2, p4 = lane & 3;
    const int cb = wid & 3, eh = wid >> 2;
    const int cl = 32 * cb + r32;
    const size_t tok = (size_t)b * SEQ + n * 128 + cl;
    bf16x8 qf[8];
#pragma unroll
    for (int kd = 0; kd < 8; ++kd) qf[kd] = *(const bf16x8*)(P + tok * NIN + h * 128 + 16 * kd + 8 * hi);
    __syncthreads();
    f32x16 O[2], XF[2], XB[2];
#pragma unroll
    for (int e = 0; e < 2; ++e)
#pragma unroll
        for (int r = 0; r < 16; ++r) { O[e][r] = 0.f; XF[e][r] = 0.f; XB[e][r] = 0.f; }
    float ff[16], fb[16];
#pragma unroll
    for (int r = 0; r < 16; ++r) { ff[r] = __builtin_amdgcn_exp2f((float)(31 - crow(r, hi)) * lgf2); fb[r] = __builtin_amdgcn_exp2f((float)crow(r, hi) * lgb2); }
    unsigned vp[2][2], sn[2][2], kb[8];
#pragma unroll
    for (int e = 0; e < 2; ++e)
#pragma unroll
        for (int tt = 0; tt < 2; ++tt) { vp[e][tt] = tr_base_perm(2 * eh + e, tt, lane); sn[e][tt] = tr_base_nat(2 * eh + e, tt, lane); }
#pragma unroll
    for (int kd = 0; kd < 8; ++kd) kb[kd] = row_base(2 * kd, lane);
#pragma unroll
    for (int mb = 0; mb < 4; ++mb) {
        f32x16 S;
#pragma unroll
        for (int r = 0; r < 16; ++r) S[r] = 0.f;
#pragma unroll
        for (int kd = 0; kd < 8; ++kd) { const bf16x8 kf = *(const LAS bf16x8*)(KT + kb[kd] + 8192 * mb); S = __builtin_amdgcn_mfma_f32_32x32x16_bf16(kf, qf[kd], S, 0, 0, 0); }
        if (mb < cb) { const float fa = __builtin_amdgcn_exp2f((float)(cl - 32 * mb - 31) * lgf2);
#pragma unroll
            for (int r = 0; r < 16; ++r) S[r] *= fa * ff[r];
        } else if (mb > cb) { const float fa = __builtin_amdgcn_exp2f((float)(32 * mb - cl) * lgb2);
#pragma unroll
            for (int r = 0; r < 16; ++r) S[r] *= fa * fb[r];
        } else {
#pragma unroll
            for (int r = 0; r < 16; ++r) { const int rel = r32 - crow(r, hi); const float d = (rel >= 0) ? (float)rel * lgf2 : (float)(-rel) * lgb2; S[r] *= __builtin_amdgcn_exp2f(d); }
        }
#pragma unroll
        for (int s = 0; s < 2; ++s) {
            const bf16x8 pk = pack8(S, s);
#pragma unroll
            for (int e = 0; e < 2; ++e) { const bf16x8 vf = tr_pair(VT + vp[e][0] + 256 * (32 * mb + 16 * s), VT + vp[e][1] + 256 * (32 * mb + 16 * s + 8)); O[e] = __builtin_amdgcn_mfma_f32_32x32x16_bf16(vf, pk, O[e], 0, 0, 0); }
        }
    }
#pragma unroll
    for (int kd = 0; kd < 8; ++kd) {
#pragma unroll
        for (int e = 0; e < 2; ++e) {
            const bf16x8 ff = tr_pair(SF + sn[e][0] + 256 * (16 * kd), SF + sn[e][1] + 256 * (16 * kd + 4)); XF[e] = __builtin_amdgcn_mfma_f32_32x32x16_bf16(ff, qf[kd], XF[e], 0, 0, 0);
            const bf16x8 fb = tr_pair(SB + sn[e][0] + 256 * (16 * kd), SB + sn[e][1] + 256 * (16 * kd + 4)); XB[e] = __builtin_amdgcn_mfma_f32_32x32x16_bf16(fb, qf[kd], XB[e], 0, 0, 0);
        }
    }
    const float xf = __builtin_amdgcn_exp2f((float)(cl + 1) * lgf2), xb = __builtin_amdgcn_exp2f((float)(128 - cl) * lgb2);
    float s1 = 0.f, s2 = 0.f;
#pragma unroll
    for (int e = 0; e < 2; ++e)
#pragma unroll
        for (int r = 0; r < 16; ++r) { const float o = O[e][r] + xf * XF[e][r] + xb * XB[e][r]; O[e][r] = o; s1 += o; s2 += o * o; }
    s1 += __shfl_xor(s1, 32); s2 += __shfl_xor(s2, 32);
    LAS f32x2* stt = (LAS f32x2*)(lds + LDS_STATS);
    if (hi == 0) stt[eh * 128 + cl] = (f32x2){s1, s2};
    __syncthreads();
    const f32x2 o2 = stt[(eh ^ 1) * 128 + cl];
    const float mu = (s1 + o2[0]) * (1.f / 128.f), var = (s2 + o2[1]) * (1.f / 128.f) - mu * mu, rstd = __builtin_amdgcn_rsqf(fmaxf(var, 0.f) + EPS);
    const float* gg = a.in[9] + l * 512 + h * 128;
    bf16* gp = P + tok * NIN + 1536 + h * 128;
#pragma unroll
    for (int e = 0; e < 2; ++e)
#pragma unroll
        for (int pr = 0; pr < 2; ++pr) {
            unsigned wv[2][2];
#pragma unroll
            for (int k = 0; k < 2; ++k) {
                const int rq = 2 * pr + k, e0 = 64 * eh + 32 * e + 8 * rq + 4 * hi;
                const u32x2 sg = *(const u32x2*)(gp + e0); const f32x4 gv = *(const f32x4*)(gg + e0);
                const float y0 = (O[e][4 * rq + 0] - mu) * rstd * gv[0] * bflo(sg.x), y1 = (O[e][4 * rq + 1] - mu) * rstd * gv[1] * bfhi(sg.x);
                const float y2 = (O[e][4 * rq + 2] - mu) * rstd * gv[2] * bflo(sg.y), y3 = (O[e][4 * rq + 3] - mu) * rstd * gv[3] * bfhi(sg.y);
                wv[k][0] = pkbf(y0, y1); wv[k][1] = pkbf(y2, y3);
            }
            const auto sx = __builtin_amdgcn_permlane32_swap(wv[0][0], wv[1][0], false, false), sy = __builtin_amdgcn_permlane32_swap(wv[0][1], wv[1][1], false, false);
            u32x4 w; w.x = sx[0]; w.y = sy[0]; w.z = sx[1]; w.w = sy[1];
            if (!dry) *(u32x4*)(gp + 64 * eh + 32 * e + 16 * pr + 8 * hi) = w;
        }
    __syncthreads();
}

__device__ __forceinline__ void dattn_setup(const Args& a, LAS unsigned char* lds, int l, int tid, int lane) {
    const float* qg = a.in[10] + l * 128, * kg = a.in[11] + l * 128, * tb = a.in[14], * lv = a.in[12] + l * 256;
    const float mq = wave_max(fmaxf(fabsf(qg[lane]), fabsf(qg[64 + lane]))), mk = wave_max(fmaxf(fabsf(kg[lane]), fabsf(kg[64 + lane])));
    const float mb = wave_max(fmaxf(tb[lane], tb[64 + lane]));
    const float M = 8.f * mq * mk + mb;
    const float s0 = wave_sum(lv[lane] * lv[64 + lane]), s1 = wave_sum(lv[128 + lane] * lv[192 + lane]);
    const float lam_init = 0.8f - 0.6f * expf(-0.3f * (float)l);
    const float lam = expf(s0) - expf(s1) + lam_init;
    LAS float* tab = (LAS float*)(lds + LDS_TAB); LAS float* misc = (LAS float*)(lds + LDS_MISC);
    for (int i = tid; i < 4 * 321; i += 512) { const int h = i / 321, k = i % 321; tab[i] = (tb[rel_bucket(k - 160) * 4 + h] - M) * LOG2E; }
    if (tid == 0) { misc[0] = lam; misc[1] = 1.f - lam_init; }
    __syncthreads();
}
#define DA_LOAD(kt) do { _Pragma("unroll") for (int i_ = 0; i_ < 2; ++i_) { const int c_ = tid + 512 * i_, row_ = c_ >> 4, ch_ = c_ & 15; \
        kr[i_] = *(const u32x4*)(kbase + (size_t)((kt) * 64 + row_) * NIN + ch_ * 8); vr[i_] = *(const u32x4*)(kbase + 512 + (size_t)((kt) * 64 + row_) * NIN + ch_ * 8); } } while (0)
#define DA_STORE(buf) do { _Pragma("unroll") for (int i_ = 0; i_ < 2; ++i_) { const int c_ = tid + 512 * i_, row_ = c_ >> 4, ch_ = c_ & 15; const unsigned o_ = offb(row_, ch_); \
        *(LAS u32x4*)(lds + (buf) * 32768 + o_) = kr[i_]; *(LAS u32x4*)(lds + (buf) * 32768 + 16384 + o_) = vr[i_]; } } while (0)
__device__ __forceinline__ void dattn_unit(const Args& a, unsigned char* ws, LAS unsigned char* lds, int l, int unit, int tid, int wid, int lane, int dry) {
    asm volatile("" : "+v"(lane), "+v"(tid));
    const int qb = unit & 15, h = (unit >> 4) & 3, b = unit >> 6;
    const int r32 = lane & 31, hi = lane >> 5, g1 = (lane >> 4) & 1, q4 = (lane & 15) >> 2, p4 = lane & 3;
    const int t = wid & 1, rg = wid >> 1;
    const int qw = qb * 128 + rg * 32;
    bf16* P = (bf16*)(ws + WS_P);
    const size_t tok = (size_t)b * SEQ + qw + r32;
    const LAS float* tab = (const LAS float*)(lds + LDS_TAB) + h * 321;
    const LAS float* misc = (const LAS float*)(lds + LDS_MISC);
    bf16x8 qf[4];
#pragma unroll
    for (int d0 = 0; d0 < 4; ++d0) qf[d0] = *(const bf16x8*)(P + tok * NIN + 2048 + h * 128 + t * 64 + 16 * d0 + 8 * hi);
    const bf16* kbase = P + (size_t)b * SEQ * NIN + 2560 + h * 128;
    f32x16 O[4];
#pragma unroll
    for (int eb = 0; eb < 4; ++eb)
#pragma unroll
        for (int r = 0; r < 16; ++r) O[eb][r] = 0.f;
    float lsum = 0.f;
    const float bneg = tab[0], bpos = tab[320];
    unsigned vp[4][2], kb[4];
#pragma unroll
    for (int c = 0; c < 4; ++c) { vp[c][0] = tr_base_perm(c, 0, lane); vp[c][1] = tr_base_perm(c, 1, lane); kb[c] = row_base(8 * t + 2 * c, lane); }
    const int rot = 2 * qb;
    int dsrc[2];
#pragma unroll
    for (int i = 0; i < 2; ++i) { const int p = (2 * wid + i) * 64 + lane, row = p >> 4, ch = (p & 15) ^ (((row & 3) << 2) | ((row >> 2) & 3)); dsrc[i] = row * NIN + ch * 8; }
#define DA_DMAK(kt, slot) do { _Pragma("unroll") for (int i_ = 0; i_ < 2; ++i_) __builtin_amdgcn_global_load_lds((const unsigned*)(kbase + (size_t)((((kt) + rot) & 31) * 64) * NIN + dsrc[i_]), \
        (LAS unsigned*)(lds + (slot) * 32768 + (2 * wid + i_) * 1024), 16, 0, 0); } while (0)
#define DA_DMAV(kt, slot) do { _Pragma("unroll") for (int i_ = 0; i_ < 2; ++i_) __builtin_amdgcn_global_load_lds((const unsigned*)(kbase + 512 + (size_t)((((kt) + rot) & 31) * 64) * NIN + dsrc[i_]), \
        (LAS unsigned*)(lds + (slot) * 32768 + 16384 + (2 * wid + i_) * 1024), 16, 0, 0); } while (0)
#define DA_WAITBAR() asm volatile("s_waitcnt vmcnt(0) lgkmcnt(0)\n\ts_barrier" ::: "memory")
#define DA_QK(kt, slot, SN) do { \
        const LAS unsigned char* KT_ = lds + (slot) * 32768; \
        bf16x8 kf_[2][4]; \
        _Pragma("unroll") for (int blk = 0; blk < 2; ++blk) _Pragma("unroll") for (int d0 = 0; d0 < 4; ++d0) kf_[blk][d0] = *(const LAS bf16x8*)(KT_ + kb[d0] + 8192 * blk); \
        _Pragma("unroll") for (int blk = 0; blk < 2; ++blk) { \
            const int k0_ = (((kt) + rot) & 31) * 64 + blk * 32, relmax_ = k0_ + 31 - qw, relmin_ = k0_ - qw - 31; \
            const float cinit_ = (relmax_ <= -91) ? bneg : ((relmin_ >= 91) ? bpos : 0.f); \
            _Pragma("unroll") for (int r = 0; r < 16; ++r) SN[blk][r] = cinit_; \
            _Pragma("unroll") for (int d0 = 0; d0 < 4; ++d0) SN[blk] = __builtin_amdgcn_mfma_f32_32x32x16_bf16(kf_[blk][d0], qf[d0], SN[blk], 0, 0, 0); \
        } } while (0)
#define DA_SB() __builtin_amdgcn_sched_barrier(0)
#define DA_VRD(blk, j) tr_pair(VT_ + vp[(j) & 3][0] + 256 * (32 * (blk) + 16 * ((j) >> 2)), VT_ + vp[(j) & 3][1] + 256 * (32 * (blk) + 16 * ((j) >> 2) + 8))
#define DA_STEP(kt, par, SC, SN, HAS_K2, HAS_V1, HAS_QK) do { \
        if (HAS_K2) DA_DMAK((kt) + 2, par); \
        if (HAS_V1) DA_DMAV((kt) + 1, (par) ^ 1); \
        const LAS unsigned char* KT_ = lds + ((par) ^ 1) * 32768; const LAS unsigned char* VT_ = lds + (par) * 32768 + 16384; \
        bf16x8 kf_[2][4], vf_[8]; \
        if (HAS_QK) { \
            _Pragma("unroll") for (int blk = 0; blk < 2; ++blk) _Pragma("unroll") for (int d0 = 0; d0 < 4; ++d0) kf_[blk][d0] = *(const LAS bf16x8*)(KT_ + kb[d0] + 8192 * blk); \
            _Pragma("unroll") for (int blk = 0; blk < 2; ++blk) { \
                const int k0_ = (((kt) + 1 + rot) & 31) * 64 + blk * 32, relmax_ = k0_ + 31 - qw, relmin_ = k0_ - qw - 31; \
                const float cinit_ = (relmax_ <= -91) ? bneg : ((relmin_ >= 91) ? bpos : 0.f); \
                _Pragma("unroll") for (int r = 0; r < 16; ++r) SN[blk][r] = cinit_; } \
        } \
        _Pragma("unroll") for (int blk = 0; blk < 2; ++blk) { \
            const int k0_ = (((kt) + rot) & 31) * 64 + blk * 32, relmax_ = k0_ + 31 - qw, relmin_ = k0_ - qw - 31; \
            if (!(relmax_ <= -91 || relmin_ >= 91)) { \
                const LAS float* tb_ = tab + (k0_ - qw - r32 + 4 * hi + 160);     \
                _Pragma("unroll") for (int r = 0; r < 16; ++r) SC[blk][r] += tb_[(r & 3) + 8 * (r >> 2)]; \
            } } \
        DA_SB(); \
        _Pragma("unroll") for (int j = 0; j < 8; ++j) { \
            __builtin_amdgcn_s_setprio(1); if (HAS_QK) SN[j >> 2] = __builtin_amdgcn_mfma_f32_32x32x16_bf16(kf_[j >> 2][j & 3], qf[j & 3], SN[j >> 2], 0, 0, 0); __builtin_amdgcn_s_setprio(0); \
            SC[0][2 * j] = __builtin_amdgcn_exp2f(SC[0][2 * j]); SC[0][2 * j + 1] = __builtin_amdgcn_exp2f(SC[0][2 * j + 1]); \
            vf_[j] = DA_VRD(0, j); \
            DA_SB(); } \
        const bf16x8 pk00_ = pack8(SC[0], 0), pk01_ = pack8(SC[0], 1); \
        DA_SB(); \
        _Pragma("unroll") for (int j = 0; j < 8; ++j) { \
            __builtin_amdgcn_s_setprio(1); O[j & 3] = __builtin_amdgcn_mfma_f32_32x32x16_bf16(vf_[j], (j >> 2) ? pk01_ : pk00_, O[j & 3], 0, 0, 0); __builtin_amdgcn_s_setprio(0); \
            SC[1][2 * j] = __builtin_amdgcn_exp2f(SC[1][2 * j]); SC[1][2 * j + 1] = __builtin_amdgcn_exp2f(SC[1][2 * j + 1]); \
            lsum += SC[0][2 * j] + SC[0][2 * j + 1]; \
            vf_[j] = DA_VRD(1, j); \
            DA_SB(); } \
        const bf16x8 pk10_ = pack8(SC[1], 0), pk11_ = pack8(SC[1], 1); \
        DA_SB(); \
        _Pragma("unroll") for (int j = 0; j < 8; ++j) { \
            __builtin_amdgcn_s_setprio(1); O[j & 3] = __builtin_amdgcn_mfma_f32_32x32x16_bf16(vf_[j], (j >> 2) ? pk11_ : pk10_, O[j & 3], 0, 0, 0); __builtin_amdgcn_s_setprio(0); \
            lsum += SC[1][2 * j] + SC[1][2 * j + 1]; \
            DA_SB(); } \
        DA_WAITBAR(); } while (0)
    f32x16 SA[2], SB[2];
    DA_DMAK(0, 0); DA_DMAV(0, 0); DA_DMAK(1, 1);
    DA_WAITBAR();
    DA_QK(0, 0, SA);
    DA_WAITBAR();
    for (int kt = 0; kt < 30; kt += 2) { DA_STEP(kt, 0, SA, SB, true, true, true); DA_STEP(kt + 1, 1, SB, SA, true, true, true); }
    DA_STEP(30, 0, SA, SB, false, true, true);
    DA_STEP(31, 1, SB, SA, false, false, false);
#undef DA_SB
#undef DA_VRD
#undef DA_STEP
#undef DA_QK
#undef DA_DMAK
#undef DA_DMAV
#undef DA_WAITBAR
    lsum += __shfl_xor(lsum, 32);
    const float lam = misc[0], oneml = misc[1];
    LAS float* Y = (LAS float*)lds + rg * 4096;
    if (t == 1) {
        const float inv = lam / lsum;
#pragma unroll
        for (int eb = 0; eb < 4; ++eb)
#pragma unroll
            for (int r = 0; r < 16; ++r) Y[(32 * eb + crow(r, hi)) * 32 + r32] = O[eb][r] * inv;
    }
    __syncthreads();
    if (t == 0 && !dry) {
        const float inv = 1.f / lsum; float ssq = 0.f;
#pragma unroll
        for (int eb = 0; eb < 4; ++eb)
#pragma unroll
            for (int r = 0; r < 16; ++r) { const float o = O[eb][r] * inv - Y[(32 * eb + crow(r, hi)) * 32 + r32]; O[eb][r] = o; ssq += o * o; }
        ssq += __shfl_xor(ssq, 32);
        const float rs = __builtin_amdgcn_rsqf(ssq * (1.f / 128.f) + EPS) * oneml;
        const float* sg = a.in[13] + l * 128;
        bf16* op = P + tok * NIN + 2048 + h * 128;
#pragma unroll
        for (int eb = 0; eb < 4; ++eb)
#pragma unroll
            for (int pr = 0; pr < 2; ++pr) {
                u32x2 wa, wb;
                { const int rq = 2 * pr, e0 = 32 * eb + 8 * rq + 4 * hi; const f32x4 gv = *(const f32x4*)(sg + e0);
                  wa.x = pkbf(O[eb][4 * rq] * rs * gv[0], O[eb][4 * rq + 1] * rs * gv[1]); wa.y = pkbf(O[eb][4 * rq + 2] * rs * gv[2], O[eb][4 * rq + 3] * rs * gv[3]); }
                { const int rq = 2 * pr + 1, e0 = 32 * eb + 8 * rq + 4 * hi; const f32x4 gv = *(const f32x4*)(sg + e0);
                  wb.x = pkbf(O[eb][4 * rq] * rs * gv[0], O[eb][4 * rq + 1] * rs * gv[1]); wb.y = pkbf(O[eb][4 * rq + 2] * rs * gv[2], O[eb][4 * rq + 3] * rs * gv[3]); }
                const auto sx = __builtin_amdgcn_permlane32_swap(wa.x, wb.x, false, false), sy = __builtin_amdgcn_permlane32_swap(wa.y, wb.y, false, false);
                u32x4 w; w.x = sx[0]; w.y = sy[0]; w.z = sx[1]; w.w = sy[1];
                *(u32x4*)(op + 32 * eb + 16 * pr + 8 * hi) = w;
            }
    }
    __syncthreads();
}

#define XB_TMO      128
#define XB_XCNT(j)  (256  + 64 * (j))
#define XB_XSUB(j)  (1280 + 64 * (j))
#define XB_XGEN(j)  (2304 + 64 * (j))
#define XB_TOP      3328
#define XB_TOPGEN   3392
#define XCD_BAR_WORDS 3456
#define XB_SPIN_CAP (1u << 18)

__device__ __forceinline__ unsigned xb_ld(unsigned* p)              { return __hip_atomic_load(p, __ATOMIC_RELAXED, __HIP_MEMORY_SCOPE_AGENT); }
__device__ __forceinline__ unsigned xb_add(unsigned* p, unsigned v) { return __hip_atomic_fetch_add(p, v, __ATOMIC_RELAXED, __HIP_MEMORY_SCOPE_AGENT); }
__device__ __forceinline__ unsigned xb_xcc_id() { return (unsigned)__builtin_amdgcn_s_getreg((3 << 11) | 20) & 0xFu; }
#define XB_SPIN(cond, bar) do { unsigned _sp = 0; while (cond) { __builtin_amdgcn_s_sleep(1); \
    if ((++_sp & 255u) == 0u) { if (xb_ld(&(bar)[XB_TMO])) break; if (_sp > XB_SPIN_CAP) { atomicAdd(&(bar)[XB_TMO], 1u); break; } } } } while (0)

struct XcdBarrier {
    unsigned* bar; unsigned x;
    volatile LAS unsigned* st;
};

__device__ __forceinline__ XcdBarrier xcd_barrier_post(unsigned* bar, volatile LAS unsigned* st) {
    XcdBarrier b; b.bar = bar; b.x = xb_xcc_id(); b.st = st;
    if (threadIdx.x == 0) (void)xb_add(&bar[XB_XCNT(b.x)], 1u);
    return b;
}
__device__ __forceinline__ void xcd_barrier_complete(unsigned* bar, unsigned x, unsigned& nloc, unsigned& nx) {
    const unsigned G = gridDim.x * gridDim.y * gridDim.z;
    unsigned sum, cnt, mine, sp = 0u;
    for (;;) {
        sum = 0u; cnt = 0u; mine = 0u;
#pragma unroll
        for (unsigned j = 0; j < 16; ++j) { const unsigned c = xb_ld(&bar[XB_XCNT(j)]); sum += c; cnt += (c > 0u) ? 1u : 0u; mine = (j == x) ? c : mine; }
        if (sum == G) break;
        __builtin_amdgcn_s_sleep(1);
        if ((++sp & 255u) == 0u) { if (xb_ld(&bar[XB_TMO])) break; if (sp > XB_SPIN_CAP) { atomicAdd(&bar[XB_TMO], 1u); break; } }
    }
    nloc = mine > 0u ? mine : 1u; nx = cnt > 0u ? cnt : 1u;
}

__device__ __forceinline__ void xcd_barrier(const XcdBarrier& b) {
    asm volatile("s_waitcnt vmcnt(0)" ::: "memory");
    __syncthreads();
    if (threadIdx.x == 0) {
        unsigned* bar = b.bar;
        __builtin_amdgcn_s_waitcnt(0);
        unsigned nloc = b.st[0], nx = b.st[1];
        if (nloc == 0u) { xcd_barrier_complete(bar, b.x, nloc, nx); b.st[0] = nloc; b.st[1] = nx; }
        const unsigned old = xb_add(&bar[XB_XSUB(b.x)], 1u);
        const unsigned gen = old / nloc;
        if (old + 1u == (gen + 1u) * nloc) {
            __builtin_amdgcn_fence(__ATOMIC_RELEASE, "agent");
            asm volatile("s_waitcnt vmcnt(0)" ::: "memory");
            const unsigned og = xb_add(&bar[XB_TOP], 1u);
            const unsigned tg = og / nx;
            if (og + 1u == (tg + 1u) * nx) xb_add(&bar[XB_TOPGEN], 1u);
            else XB_SPIN(xb_ld(&bar[XB_TOPGEN]) == tg, bar);
            __builtin_amdgcn_fence(__ATOMIC_ACQUIRE, "agent");
            xb_add(&bar[XB_XGEN(b.x)], 1u);
            asm volatile("s_waitcnt vmcnt(0)" ::: "memory");
        } else {
            XB_SPIN(xb_ld(&bar[XB_XGEN(b.x)]) == gen, bar);
            __builtin_amdgcn_fence(__ATOMIC_ACQUIRE, "agent");
            asm volatile("s_waitcnt vmcnt(0)" ::: "memory");
        }
    }
    __syncthreads();
}

#ifndef PROBE_DUP
#define PROBE_DUP 0
#endif
template <int PHM, int PH> __device__ __forceinline__ void run_phase(const Args& a, LAS unsigned char* lds0, int dry) {
    int tid = threadIdx.x; asm volatile("" : "+v"(tid));
    const int lane = tid & 63, wid = __builtin_amdgcn_readfirstlane(tid >> 6);
    int z_; asm volatile("s_mov_b32 %0, 0" : "=s"(z_));
    unsigned char* ws = a.ws + z_;
    LAS unsigned char* lds = lds0 + z_;
    const int G = (int)gridDim.x + z_, bx = (int)blockIdx.x + z_;
    const int vcu = (G % 8 == 0) ? (bx % 8) * (G / 8) + bx / 8 : bx;
    float* outp = (float*)((unsigned char*)a.out + z_);
    u64* stat = (u64*)(ws + WS_STAT); bf16* hb = (bf16*)(ws + WS_HB); bf16* P = (bf16*)(ws + WS_P);
    if constexpr (PH == 0) { if constexpr ((PHM & 1) != 0) phase_prep(a, ws, lds, vcu, G, tid, wid, lane); }
    else {
        constexpr int l = (PH - 1) / 10, sp = (PH - 1) % 10;
        unsigned char* wl = ws + WS_W + (size_t)l * W_LAYER;
        if constexpr ((PHM & 2) != 0 && (sp == 0 || sp == 7)) {
            pg8::Gemm g{hb, (const bf16*)(wl + (sp == 0 ? WO_GU1 : WO_GU2)), T, 2 * FF, DM, DM};
            pg8::StaticOrder S; S.init(T, 2 * FF, G, bx);
            constexpr bool NN = (l > 0 && sp == 0);
            EpiSwiGLU<NN> E{P, stat + (size_t)(NN ? (l - 1) * 4 + 3 : l * 4 + (sp == 0 ? 0 : 2)) * T, stat + (size_t)(l * 4) * T};
            pg8::gemm_phase<EpiSwiGLU<NN>, pg8::StaticOrder, true, true>(lds, g, S, E, tid);
        } else if constexpr ((PHM & 4) != 0 && (sp == 1 || sp == 8 || sp == 6)) {
            pg8::Gemm g{sp == 6 ? P + 1536 : P, (const bf16*)(wl + (sp == 1 ? WO_D1 : (sp == 8 ? WO_D2 : WO_OUT))), T, DM, sp == 6 ? DM : FF, sp == 6 ? NIN : FF};
            pg8::StaticOrder S; S.init(T, DM, G, bx);
            constexpr int MODE = (sp == 8 && l + 1 < 2) ? 1 : ((sp == 1 && l > 0) ? 2 : 0);
            constexpr int lg = (MODE == 1) ? l : (l > 0 ? l - 1 : 0);
            constexpr bool WF32 = false;
            EpiRes<MODE, WF32> E{outp, hb, stat + (size_t)(l * 4 + (sp == 1 ? 1 : (sp == 6 ? 2 : 3))) * T, dry,
                           a.in[20] + lg * DM, stat + (size_t)(lg * 4 + 3) * T, stat + (size_t)((l + 1) * 4) * T};
            pg8::gemm_phase<EpiRes<MODE, WF32>, pg8::StaticOrder, true, true>(lds, g, S, E, tid);
        } else if constexpr ((PHM & 8) != 0 && sp == 2) {
            pg8::Gemm g{hb, (const bf16*)(wl + WO_IN), T, NIN, DM, DM};
            pg8::StaticOrder S; S.init(T, NIN, G, bx);
            EpiWin E{P, stat + (size_t)(l * 4 + 1) * T, (const f32x2*)(ws + WS_ROT), a.in[10] + l * 128, a.in[11] + l * 128};
            pg8::gemm_phase<EpiWin, pg8::StaticOrder, true, true>(lds, g, S, E, tid);
        } else if constexpr ((PHM & 16) != 0 && sp == 3) {
            for (int u = vcu; u < NB * 64; u += G) r1_unit(a, ws, (bf16*)outp, lds, l, u, tid, wid, lane);
        } else if constexpr ((PHM & 32) != 0 && sp == 4) {
            phase_scan(a, ws, (bf16*)outp, l, vcu, G, tid, z_);
        } else if constexpr (sp == 5) {
            if constexpr ((PHM & 64) != 0) { dattn_setup(a, lds, l, tid, lane);
                for (int u = vcu; u < NB * 64; u += G) dattn_unit(a, ws, lds, l, u, tid, wid, lane, dry); }
            if constexpr ((PHM & 128) != 0) { for (int u = vcu; u < NB * 64; u += G) r2_unit(a, ws, (bf16*)outp, lds, l, u, tid, wid, lane, dry); }
        } else if constexpr ((PHM & 256) != 0 && sp == 9 && l == 1) {
            phase_fnorm(a, ws, outp, l, vcu, G, wid, lane);
        }
    }
}
template <int PHM> __global__ void __launch_bounds__(512) fwd_kernel(Args a0) {
    extern __shared__ __attribute__((aligned(16))) unsigned char lds_raw[];
    LAS unsigned char* lds0 = (LAS unsigned char*)lds_raw;
    cg::grid_group grid = cg::this_grid();
    const int lo = a0.lo, hi = a0.hi;
    if (threadIdx.x < 2) ((LAS unsigned*)(lds0 + LDS_BARW))[threadIdx.x] = 0u;
    __syncthreads();
    XcdBarrier xbar; xbar.bar = (unsigned*)(a0.ws + WS_BAR); xbar.x = 0; xbar.st = (volatile LAS unsigned*)(lds0 + LDS_BARW);
    if (hi - lo > 1) xbar = xcd_barrier_post((unsigned*)(a0.ws + WS_BAR), (volatile LAS unsigned*)(lds0 + LDS_BARW));
#define RUN(k) if ((k) != 10 && lo <= (k) && (k) < hi) { run_phase<PHM, (k)>(a0, lds0, a0.dry); if ((k) + 1 < hi) { if ((k) == 0) grid.sync(); else xcd_barrier(xbar); } }
    RUN(0) RUN(1) RUN(2) RUN(3) RUN(4) RUN(5) RUN(6) RUN(7) RUN(8) RUN(9) RUN(10)
    RUN(11) RUN(12) RUN(13) RUN(14) RUN(15) RUN(16) RUN(17) RUN(18) RUN(19) RUN(20)
#undef RUN
}

#ifndef N_LAUNCH_MODE
#define N_LAUNCH_MODE 1
#endif
template <int PHM> static void launch_one(const Args& a, int grid, hipStream_t stream) { hipLaunchKernelGGL(fwd_kernel<PHM>, dim3(grid), dim3(512), LDS_BYTES, stream, a); }
template <int PHM> static void set_lds() { (void)hipFuncSetAttribute((const void*)fwd_kernel<PHM>, hipFuncAttributeMaxDynamicSharedMemorySize, LDS_BYTES); }
extern "C" void kernel_launch(void* const* d_in, const int* in_sizes, int n_in, void* d_out, int out_size, void* d_ws, size_t ws_size, hipStream_t stream) {
    static int grid = 0;
    if (grid == 0) {
        if (n_in != 21 || ws_size < WS_END) { fprintf(stderr, "kernel_launch: unexpected inputs (n_in %d, ws %zu)\n", n_in, ws_size); grid = -1; return; }
        int dev = 0, cus = 0, per_cu = 0;
        (void)hipGetDevice(&dev); (void)hipDeviceGetAttribute(&cus, hipDeviceAttributeMultiprocessorCount, dev);
#if N_LAUNCH_MODE == 1
        set_lds<511>();
        (void)hipOccupancyMaxActiveBlocksPerMultiprocessor(&per_cu, (const void*)fwd_kernel<511>, 512, LDS_BYTES);
#else
        set_lds<1>(); set_lds<2>(); set_lds<4>(); set_lds<8>(); set_lds<16>(); set_lds<32>(); set_lds<64>(); set_lds<128>(); set_lds<256>();
        per_cu = 1;
#endif
        if (per_cu < 1) { fprintf(stderr, "kernel_launch: occupancy query returned %d\n", per_cu); per_cu = 1; }
        (void)hipGetLastError();
        grid = cus * per_cu;
    }
    if (grid < 0) return;
    Args a{};
    for (int i = 0; i < 21; ++i) a.in[i] = (const float*)d_in[i];
    a.out = (float*)d_out; a.ws = (unsigned char*)d_ws;
#if N_LAUNCH_MODE == 1
    (void)hipMemsetAsync((unsigned char*)d_ws + WS_BAR, 0, WS_BAR_BYTES, stream);
    a.lo = 0; a.hi = NPHASE;
    void* args[] = {&a};
    hipError_t e = hipLaunchCooperativeKernel((const void*)fwd_kernel<511>, dim3(grid), dim3(512), args, LDS_BYTES, stream);
    if (e != hipSuccess) fprintf(stderr, "cooperative launch failed: %s (grid %d)\n", hipGetErrorString(e), grid);
#else
    for (int ph = 0; ph < NPHASE; ++ph) {
        a.lo = ph; a.hi = ph + 1;
        const int sp = ph == 0 ? 11 : (ph - 1) % 10;
        const int nrep = 1 + ((PROBE_DUP >> sp) & 1), nrepB = 1 + ((PROBE_DUP >> 10) & 1);
        for (int rep = 0; rep < nrep; ++rep) {
            a.dry = (rep + 1 < nrep) ? 1 : 0;
            if (ph == 0) launch_one<1>(a, grid, stream);
            else if (sp == 0 || sp == 7) launch_one<2>(a, grid, stream);
            else if (sp == 1 || sp == 8 || sp == 6) launch_one<4>(a, grid, stream);
            else if (sp == 2) launch_one<8>(a, grid, stream);
            else if (sp == 3) launch_one<16>(a, grid, stream);
            else if (sp == 4) launch_one<32>(a, grid, stream);
            else if (sp == 5) { launch_one<64>(a, grid, stream); if (rep == 0) for (int rb = 0; rb < nrepB; ++rb) { Args b = a; b.dry = (rb + 1 < nrepB) ? 1 : 0; launch_one<128>(b, grid, stream); } }
            else launch_one<256>(a, grid, stream);
        }
    }
#endif
}
```

```cpp
#include <hip/hip_runtime.h>
#include <hip/hip_cooperative_groups.h>
#include <cstdio>
#include <cstdint>
namespace cg = cooperative_groups;
namespace pg8 {
#define PG8_LAS __attribute__((address_space(3)))
typedef unsigned short bf16_t;
typedef short bf16x8 __attribute__((ext_vector_type(8)));
typedef float f32x4 __attribute__((ext_vector_type(4)));
typedef unsigned u32x4 __attribute__((ext_vector_type(4)));
constexpr int BM = 256, BK = 64, HALF = 128, HTB = HALF * BK * 2  , STAGE_BYTES = 8 * HTB, NXCD = 8, WGM = 8;

__host__ __device__ __forceinline__ int lds_byte(int r, int c) { const int st = (r >> 4) * 2 + (c >> 5), rr = r & 15, cc = c & 31, ob = rr * 64 + cc * 2; return st * 1024 + (ob ^ (((ob >> 9) & 1) << 5)); }
__host__ __device__ __forceinline__ void stage_rc(int b, int& R, int& C) { const int st = b / 1024, sb = b % 1024, swz = sb ^ (((sb >> 9) & 1) << 5); R = (st >> 1) * 16 + swz / 64; C = (st & 1) * 32 + (swz % 64) / 2; }
__host__ __device__ __forceinline__ int perm32(int rho) { const int n = rho >> 4, i = rho & 15; return 8 * (i >> 2) + 4 * n + (i & 3); }

struct Unit { int pm, pn; };
struct Gemm { const bf16_t* A; const bf16_t* Bt; int M, N, K, lda; };

struct StaticOrder {
    int nM, nN, nwg, G, c;
    __host__ __device__ void init(int M, int N, int G_, int c_) { nM = M / BM; nN = N / BM; nwg = nM * nN; G = G_; c = c_; }
    __host__ __device__ bool next(int i, Unit& u) const {
        const long L = (long)i * G + c; if (L >= nwg) return false;
        int wgid = (int)L; { const int q = nwg / NXCD, r = nwg % NXCD, xcd = wgid % NXCD, off = wgid / NXCD; wgid = (xcd < r ? xcd * (q + 1) : r * (q + 1) + (xcd - r) * q) + off; }
        const int nig = WGM * nN, gid = wgid / nig, fm = gid * WGM, gsz = (nM - fm) < WGM ? (nM - fm) : WGM;
        u.pm = fm + ((wgid % nig) % gsz); u.pn = (wgid % nig) / gsz; return true;
    }
    __device__ __forceinline__ void a_ready(const Unit&) const {}
    __device__ __forceinline__ void done(const Unit&) const {}
};

__device__ __forceinline__ unsigned cvt_pk_bf16(float lo, float hi) { unsigned r; asm volatile("v_cvt_pk_bf16_f32 %0, %1, %2" : "=v"(r) : "v"(lo), "v"(hi)); return r; }
typedef float f32x2 __attribute__((ext_vector_type(2)));
template <class Epi, class Sched, bool ALIGN_EPI = false, bool SP2 = false>
__device__ __forceinline__ void gemm_phase(PG8_LAS unsigned char* lds, const Gemm g, const Sched& S, const Epi& E, const int tid) {
    const int wid = __builtin_amdgcn_readfirstlane(tid >> 6), lane = tid & 63, wr = wid >> 2, wc = wid & 3, fr = lane & 15, fq = lane >> 4;
    const int K = g.K, nt = K / BK;
    unsigned voffA[2], voffB[2];
#pragma unroll
    for (int i = 0; i < 2; ++i) { int R, C; stage_rc(tid * 16 + i * 8192, R, C); const int Rb = Epi::PERM ? ((R & ~31) + perm32(R & 31)) : R;
        voffA[i] = (unsigned)(R * g.lda + C) * 2u; voffB[i] = (unsigned)(Rb * K + C) * 2u; }
    const size_t kstep = (size_t)(BK * 2);
    const size_t hstep = (size_t)HALF * K * 2;
    const size_t tstep = 2 * hstep; const size_t hstepA = (size_t)HALF * g.lda * 2, tstepA = 2 * hstepA;
    const unsigned ldsw = (unsigned)wid * 1024u;
    const int aoff = lds_byte(wr * 64 + fr, fq * 8), boff = lds_byte(wc * 32 + fr, fq * 8);
#define PG8_SA(b, h) (((b) * 2 + (h)) * HTB)
#define PG8_SB(b, h) ((4 + (b) * 2 + (h)) * HTB)
#define PG8_STAGE(bufoff, gbase, voff) do { _Pragma("unroll") for (int _i = 0; _i < 2; ++_i) \
        __builtin_amdgcn_global_load_lds((const unsigned*)((const char*)(gbase) + (voff)[_i]), (PG8_LAS unsigned*)(lds + (bufoff) + ldsw + _i * 8192), 16, 0, 0); } while (0)
#define PG8_LDA(dst, b, h) do { _Pragma("unroll") for (int m = 0; m < 4; ++m) _Pragma("unroll") for (int k = 0; k < 2; ++k) dst[m][k] = *(const PG8_LAS bf16x8*)(lds + PG8_SA(b, h) + aoff + m * 2048 + k * 1024); } while (0)
#define PG8_LDB(dst, b, h) do { _Pragma("unroll") for (int n = 0; n < 2; ++n) _Pragma("unroll") for (int k = 0; k < 2; ++k) dst[n][k] = *(const PG8_LAS bf16x8*)(lds + PG8_SB(b, h) + boff + n * 2048 + k * 1024); } while (0)
#define PG8_MMA(ai, bj, At, Bt) do { __builtin_amdgcn_s_setprio(1); _Pragma("unroll") for (int m = 0; m < 4; ++m) _Pragma("unroll") for (int n = 0; n < 2; ++n) _Pragma("unroll") for (int k = 0; k < 2; ++k) \
        acc[ai][bj][m][n] = __builtin_amdgcn_mfma_f32_16x16x32_bf16(Bt[n][k], At[m][k], acc[ai][bj][m][n], 0, 0, 0); __builtin_amdgcn_s_setprio(0); } while (0)
#define PG8_WAIT_V(n) asm volatile("s_waitcnt vmcnt(" #n ")" ::: "memory")
#define PG8_WAIT_L(n) asm volatile("s_waitcnt lgkmcnt(" #n ")" ::: "memory")
#define PG8_BAR __builtin_amdgcn_s_barrier()
#define PG8_SCHED __builtin_amdgcn_sched_barrier(0)
    Unit cur, nxt; int ui = 0;
    if (!S.next(0, cur)) return;
    f32x4 acc[2][2][4][2];
#pragma unroll
    for (int a = 0; a < 2; ++a)
#pragma unroll
        for (int b = 0; b < 2; ++b)
#pragma unroll
            for (int m = 0; m < 4; ++m)
#pragma unroll
                for (int n = 0; n < 2; ++n) acc[a][b][m][n] = (f32x4){0.f, 0.f, 0.f, 0.f};
    bf16x8 At[4][2], B0[2][2], B1[2][2];
    const char* cA = (const char*)g.A + (size_t)cur.pm * tstepA; const char* cB = (const char*)g.Bt + (size_t)cur.pn * tstep;
    S.a_ready(cur);
    if constexpr (SP2) {
        PG8_STAGE(PG8_SB(0, 0), cB, voffB); PG8_STAGE(PG8_SB(0, 1), cB + hstep, voffB); PG8_STAGE(PG8_SA(0, 0), cA, voffA); PG8_STAGE(PG8_SA(0, 1), cA + hstepA, voffA);
        if (wr == 1) PG8_BAR;
        PG8_WAIT_V(2); PG8_BAR;
        PG8_STAGE(PG8_SB(1, 0), cB + kstep, voffB); PG8_STAGE(PG8_SA(1, 0), cA + kstep, voffA); PG8_STAGE(PG8_SB(1, 1), cB + hstep + kstep, voffB);
        PG8_WAIT_V(6); PG8_BAR;
    } else {
        PG8_STAGE(PG8_SB(0, 0), cB, voffB); PG8_STAGE(PG8_SA(0, 0), cA, voffA); PG8_STAGE(PG8_SB(0, 1), cB + hstep, voffB); PG8_STAGE(PG8_SA(0, 1), cA + hstepA, voffA);
        if (wr == 1) PG8_BAR;
        PG8_WAIT_V(4); PG8_BAR;
        PG8_STAGE(PG8_SB(1, 0), cB + kstep, voffB); PG8_STAGE(PG8_SA(1, 0), cA + kstep, voffA); PG8_STAGE(PG8_SB(1, 1), cB + hstep + kstep, voffB);
        PG8_WAIT_V(6); PG8_BAR;
    }
    for (;;) {
        const bool has_next = S.next(ui + 1, nxt);
        const char* nA = has_next ? (const char*)g.A + (size_t)nxt.pm * tstepA : cA; const char* nB = has_next ? (const char*)g.Bt + (size_t)nxt.pn * tstep : cB;
        for (int t = 0; t < nt; t += 2) {
            const bool last = (t == nt - 2);
            const char* a1 = cA + (size_t)(t + 1) * kstep;
            const char* a2 = last ? nA : cA + (size_t)(t + 2) * kstep; const char* b2 = last ? nB : cB + (size_t)(t + 2) * kstep;
            const char* a3 = a2 + kstep; const char* b3 = b2 + kstep;
            if (last && has_next) S.a_ready(nxt);
            if constexpr (SP2) {
            PG8_LDB(B0, 0, 0); PG8_LDB(B1, 0, 1); PG8_SCHED; PG8_LDA(At, 0, 0); PG8_STAGE(PG8_SA(1, 1), a1 + hstepA, voffA);
            PG8_WAIT_V(8); PG8_WAIT_L(0); PG8_BAR; PG8_MMA(0, 0, At, B0); PG8_MMA(0, 1, At, B1); PG8_BAR; PG8_SCHED;
            PG8_LDA(At, 0, 1); PG8_STAGE(PG8_SB(0, 0), b2, voffB); PG8_STAGE(PG8_SB(0, 1), b2 + hstep, voffB); PG8_STAGE(PG8_SA(0, 0), a2, voffA);
            PG8_WAIT_V(8); PG8_WAIT_L(0); PG8_BAR; PG8_MMA(1, 0, At, B0); PG8_MMA(1, 1, At, B1); PG8_BAR; PG8_SCHED;
            PG8_LDB(B0, 1, 0); PG8_LDB(B1, 1, 1); PG8_SCHED; PG8_LDA(At, 1, 0); PG8_STAGE(PG8_SA(0, 1), a2 + hstepA, voffA);
            PG8_WAIT_V(8); PG8_WAIT_L(0); PG8_BAR; PG8_MMA(0, 0, At, B0); PG8_MMA(0, 1, At, B1); PG8_BAR; PG8_SCHED;
            PG8_LDA(At, 1, 1); PG8_STAGE(PG8_SB(1, 0), b3, voffB); PG8_STAGE(PG8_SB(1, 1), b3 + hstep, voffB); PG8_STAGE(PG8_SA(1, 0), a3, voffA);
            PG8_WAIT_V(8); PG8_WAIT_L(0); PG8_BAR; PG8_MMA(1, 0, At, B0); PG8_MMA(1, 1, At, B1); PG8_BAR; PG8_SCHED;
            } else {
            PG8_LDB(B0, 0, 0); PG8_SCHED; PG8_LDA(At, 0, 0); PG8_STAGE(PG8_SA(1, 1), a1 + hstepA, voffA);
            PG8_WAIT_L(8); PG8_BAR; PG8_WAIT_L(0); PG8_MMA(0, 0, At, B0); PG8_BAR; PG8_SCHED;
            PG8_LDB(B1, 0, 1); PG8_STAGE(PG8_SB(0, 0), b2, voffB);
            PG8_BAR; PG8_WAIT_L(0); PG8_MMA(0, 1, At, B1); PG8_BAR;
            PG8_LDA(At, 0, 1); PG8_STAGE(PG8_SA(0, 0), a2, voffA);
            PG8_BAR; PG8_WAIT_L(0); PG8_MMA(1, 0, At, B0); PG8_BAR; PG8_SCHED;
            PG8_STAGE(PG8_SB(0, 1), b2 + hstep, voffB);
            PG8_WAIT_V(6); PG8_BAR; PG8_MMA(1, 1, At, B1); PG8_BAR;
            PG8_LDB(B0, 1, 0); PG8_SCHED; PG8_LDA(At, 1, 0); PG8_STAGE(PG8_SA(0, 1), a2 + hstepA, voffA);
            PG8_WAIT_L(8); PG8_BAR; PG8_WAIT_L(0); PG8_MMA(0, 0, At, B0); PG8_BAR; PG8_SCHED;
            PG8_LDB(B1, 1, 1); PG8_STAGE(PG8_SB(1, 0), b3, voffB);
            PG8_BAR; PG8_WAIT_L(0); PG8_MMA(0, 1, At, B1); PG8_BAR;
            PG8_LDA(At, 1, 1); PG8_STAGE(PG8_SA(1, 0), a3, voffA);
            PG8_BAR; PG8_WAIT_L(0); PG8_MMA(1, 0, At, B0); PG8_BAR; PG8_SCHED;
            PG8_STAGE(PG8_SB(1, 1), b3 + hstep, voffB);
            PG8_WAIT_V(6); PG8_BAR; PG8_MMA(1, 1, At, B1); PG8_BAR;
            }
        }
        if constexpr (ALIGN_EPI) { if (wr == 0) PG8_BAR; }
        if constexpr (!Epi::AFTER_DRAIN) { E(acc, cur, wr, wc, fr, fq); S.done(cur); }
        if (!has_next) break;
#pragma unroll
        for (int a = 0; a < 2; ++a)
#pragma unroll
            for (int b = 0; b < 2; ++b)
#pragma unroll
                for (int m = 0; m < 4; ++m)
#pragma unroll
                    for (int n = 0; n < 2; ++n) acc[a][b][m][n] = (f32x4){0.f, 0.f, 0.f, 0.f};
        cur = nxt; cA = nA; cB = nB; ++ui;
        if constexpr (ALIGN_EPI) { if (wr == 1) PG8_BAR; }
    }
    PG8_WAIT_V(0);
    if constexpr (!ALIGN_EPI) { if (wr == 0) PG8_BAR; }
    PG8_BAR;
    if constexpr (Epi::AFTER_DRAIN) { E.fused(acc, cur, wr, wc, fr, fq, lds, wid, lane); S.done(cur); }
#undef PG8_SA
#undef PG8_SB
#undef PG8_STAGE
#undef PG8_LDA
#undef PG8_LDB
#undef PG8_MMA
#undef PG8_WAIT_V
#undef PG8_WAIT_L
#undef PG8_BAR
#undef PG8_SCHED
}
}

#define LAS __attribute__((address_space(3)))
typedef unsigned short bf16;
typedef short bf16x8 __attribute__((ext_vector_type(8)));
typedef short v4i16_t __attribute__((ext_vector_type(4)));
typedef float f32x4 __attribute__((ext_vector_type(4)));
typedef float f32x2 __attribute__((ext_vector_type(2)));
typedef float f32x16 __attribute__((ext_vector_type(16)));
typedef unsigned u32x4 __attribute__((ext_vector_type(4)));
typedef unsigned u32x2 __attribute__((ext_vector_type(2)));

constexpr int T = 98304, TP = 32768, DM = 1024, FF = 2816, NIN = 3584, SEQ = 2048, NB = 48;
constexpr float EPS = 1e-6f, LOG2E = 1.4426950408889634f;
constexpr float C2 = 0.125f * LOG2E;
constexpr size_t MiB = 1u << 20;
constexpr size_t WS_STAT = 8 * MiB  , WS_ROT = 4 * MiB, WS_W = 16 * MiB, W_LAYER = 42 * MiB, WS_HB = 104 * MiB, WS_P = 296 * MiB, WS_END = 968 * MiB;
constexpr size_t WO_GU1 = 0, WO_D1 = 11534336, WO_IN = WO_D1 + 5767168, WO_OUT = WO_IN + 7340032, WO_GU2 = WO_OUT + 2097152, WO_D2 = WO_GU2 + 11534336;
static_assert(WO_D2 + 5767168 == W_LAYER, "weight map");
constexpr int LDS_BYTES = 147456;
constexpr int LDS_TAB = 131072, LDS_MISC = 139264, LDS_STATS = 131072, LDS_BARW = 143360;
constexpr size_t WS_BAR = 5 * MiB, WS_BAR_BYTES = 16384;
constexpr int NPHASE = 21;

typedef unsigned long long u64;
__device__ __forceinline__ float ss_scale(const u64* ss, int row) { return __builtin_amdgcn_rsqf((float)ss[row] * (1.f / 4294967296.f / 1024.f) + EPS); }
__device__ __forceinline__ u64 ss_fix(float q) { return (u64)(q * 4294967296.f); }
struct Args { const float* in[21]; float* out; unsigned char* ws; int lo, hi, dry, pad; };

#define LDS_WAIT() asm volatile("s_waitcnt lgkmcnt(0)" ::: "memory")

__device__ __forceinline__ unsigned pkbf(float lo, float hi) { typedef __bf16 bf2_t __attribute__((ext_vector_type(2))); f32x2 v = {lo, hi}; bf2_t b = __builtin_convertvector(v, bf2_t); return __builtin_bit_cast(unsigned, b); }
__device__ __forceinline__ float bflo(unsigned u) { return __builtin_bit_cast(float, u << 16); }
__device__ __forceinline__ float bfhi(unsigned u) { return __builtin_bit_cast(float, u & 0xffff0000u); }
__device__ __forceinline__ float wave_sum(float v) {
#pragma unroll
    for (int o = 1; o < 64; o <<= 1) v += __shfl_xor(v, o);
    return v;
}
__device__ __forceinline__ float wave_max(float v) {
#pragma unroll
    for (int o = 1; o < 64; o <<= 1) v = fmaxf(v, __shfl_xor(v, o));
    return v;
}
__device__ __forceinline__ float silu_f(float g) { return g * __builtin_amdgcn_rcpf(1.f + __builtin_amdgcn_exp2f(-g * LOG2E)); }
__device__ __forceinline__ int crow(int r, int hi) { return (r & 3) + 8 * (r >> 2) + 4 * hi; }
__device__ __forceinline__ unsigned offb(unsigned row, unsigned ch) { return 256u * row + 16u * (ch ^ (((row & 3u) << 2) | ((row >> 2) & 3u))); }
__device__ __forceinline__ unsigned tr_base_perm(int c, int tt, int lane) {
    const unsigned hi = lane >> 5, g1 = (lane >> 4) & 1, q4 = (lane & 15) >> 2, p4 = lane & 3, lowc = 2 * g1 + (p4 >> 1);
    return 1024u * hi + 256u * q4 + 8u * (p4 & 1) + 64u * ((unsigned)c ^ q4) + 16u * ((lowc ^ hi) ^ (2u * tt));
}
__device__ __forceinline__ unsigned tr_base_nat(int c, int tt, int lane) {
    const unsigned hi = lane >> 5, g1 = (lane >> 4) & 1, q4 = (lane & 15) >> 2, p4 = lane & 3, lowc = 2 * g1 + (p4 >> 1);
    return 2048u * hi + 256u * q4 + 8u * (p4 & 1) + 64u * ((unsigned)c ^ q4) + 16u * ((lowc ^ (2u * hi)) ^ (unsigned)tt);
}
__device__ __forceinline__ unsigned row_base(int cK, int lane) {
    const unsigned r32 = lane & 31, hi = lane >> 5, xk = ((r32 & 3u) << 2) | ((r32 >> 2) & 3u);
    return 256u * r32 + 16u * (((unsigned)cK + hi) ^ xk);
}
__device__ __forceinline__ bf16x8 tr_pair(const LAS unsigned char* p0, const LAS unsigned char* p1) {
    const v4i16_t lo = __builtin_amdgcn_ds_read_tr16_b64_v4i16((LAS v4i16_t*)p0);
    const v4i16_t hi = __builtin_amdgcn_ds_read_tr16_b64_v4i16((LAS v4i16_t*)p1);
    return (bf16x8){lo[0], lo[1], lo[2], lo[3], hi[0], hi[1], hi[2], hi[3]};
}
__device__ __forceinline__ bf16x8 pack8(const f32x16& S, int s) {
    u32x4 w; w.x = pkbf(S[8 * s + 0], S[8 * s + 1]); w.y = pkbf(S[8 * s + 2], S[8 * s + 3]); w.z = pkbf(S[8 * s + 4], S[8 * s + 5]); w.w = pkbf(S[8 * s + 6], S[8 * s + 7]);
    return __builtin_bit_cast(bf16x8, w);
}
__device__ __forceinline__ int rel_bucket(int rel) {
    const int n = rel < 0 ? -rel : rel; int b;
    if (n < 8) b = n; else if (n < 12) b = 8; else if (n < 16) b = 9; else if (n < 23) b = 10; else if (n < 32) b = 11; else if (n < 46) b = 12; else if (n < 64) b = 13; else if (n < 91) b = 14; else b = 15;
    return b + (rel > 0 ? 16 : 0);
}

template <bool NN> struct EpiSwiGLU {
    static constexpr bool PERM = true, AFTER_DRAIN = false;
    bf16* O; const u64* ss; const u64* ssw;
    __device__ __forceinline__ void operator()(const f32x4 (&acc)[2][2][4][2], const pg8::Unit& u, int wr, int wc, int fr, int fq) const {
        const int row0 = u.pm * 256 + wr * 64 + fr, col0 = u.pn * 128 + wc * 32 + 8 * fq;
#pragma unroll
        for (int ai = 0; ai < 2; ++ai)
#pragma unroll
            for (int m = 0; m < 4; ++m) {
                const int row = row0 + ai * 128 + m * 16;
                float s = ss_scale(ss, row);
                if constexpr (NN) s *= __builtin_amdgcn_rsqf(s * s * (float)ssw[row] * (1.f / 4294967296.f / 1024.f) + EPS);
                float a[8];
#pragma unroll
                for (int n = 0; n < 2; ++n)
#pragma unroll
                    for (int i = 0; i < 4; ++i) { const float g = acc[ai][0][m][n][i] * s, uu = acc[ai][1][m][n][i] * s; a[4 * n + i] = silu_f(g) * uu; }
                u32x4 w; w.x = pkbf(a[0], a[1]); w.y = pkbf(a[2], a[3]); w.z = pkbf(a[4], a[5]); w.w = pkbf(a[6], a[7]);
                *(u32x4*)(O + (size_t)row * FF + col0) = w;
            }
    }
};
template <int MODE, bool WF32> struct EpiRes {
    static constexpr bool PERM = true, AFTER_DRAIN = false;
    float* out; bf16* hb; u64* ssn; int dry; const float* gf; const u64* rss; u64* ssw;
    __device__ __forceinline__ void operator()(const f32x4 (&acc)[2][2][4][2], const pg8::Unit& u, int wr, int wc, int fr, int fq) const {
        if (dry) return;
        const int row0 = u.pm * 256 + wr * 64 + fr, col0 = u.pn * 256 + wc * 32 + 8 * fq;
        f32x4 g0[2], g1[2];
        if constexpr (MODE != 0) {
#pragma unroll
            for (int bj = 0; bj < 2; ++bj) { g0[bj] = *(const f32x4*)(gf + col0 + bj * 128); g1[bj] = *(const f32x4*)(gf + col0 + bj * 128 + 4); if constexpr (MODE == 1) { g0[bj] = g0[bj] * g0[bj]; g1[bj] = g1[bj] * g1[bj]; } }
        }
#pragma unroll
        for (int ai = 0; ai < 2; ++ai)
#pragma unroll
            for (int m = 0; m < 4; ++m) {
                const int row = row0 + ai * 128 + m * 16;
                float q = 0.f, qw = 0.f, sh = 1.f;
                if constexpr (MODE == 2) sh = ss_scale(rss, row);
#pragma unroll
                for (int bj = 0; bj < 2; ++bj) {
                    const int c = col0 + bj * 128;
                    const u32x4 rb = *(const u32x4*)(hb + (size_t)row * DM + c);
                    f32x4 r0 = {bflo(rb.x), bfhi(rb.x), bflo(rb.y), bfhi(rb.y)}, r1 = {bflo(rb.z), bfhi(rb.z), bflo(rb.w), bfhi(rb.w)};
                    if constexpr (MODE == 2) { r0 = r0 * sh * g0[bj]; r1 = r1 * sh * g1[bj]; }
                    const f32x4 v0 = r0 + acc[ai][bj][m][0], v1 = r1 + acc[ai][bj][m][1];
                    if constexpr (WF32) { *(f32x4*)(out + (size_t)row * DM + c) = v0; *(f32x4*)(out + (size_t)row * DM + c + 4) = v1; }
                    u32x4 w; w.x = pkbf(v0[0], v0[1]); w.y = pkbf(v0[2], v0[3]); w.z = pkbf(v1[0], v1[1]); w.w = pkbf(v1[2], v1[3]);
                    *(u32x4*)(hb + (size_t)row * DM + c) = w;
                    const f32x4 s0 = v0 * v0, s1 = v1 * v1;
                    q += (s0[0] + s0[1]) + (s0[2] + s0[3]) + (s1[0] + s1[1]) + (s1[2] + s1[3]);
                    if constexpr (MODE == 1) { const f32x4 t0 = s0 * g0[bj], t1 = s1 * g1[bj]; qw += (t0[0] + t0[1]) + (t0[2] + t0[3]) + (t1[0] + t1[1]) + (t1[2] + t1[3]); }
                }
                q += __shfl_xor(q, 16); q += __shfl_xor(q, 32);
                if constexpr (MODE == 1) { qw += __shfl_xor(qw, 16); qw += __shfl_xor(qw, 32); }
                if (fq == 0) {
                    __hip_atomic_fetch_add(ssn + row, ss_fix(q), __ATOMIC_RELAXED, __HIP_MEMORY_SCOPE_AGENT);
                    if constexpr (MODE == 1) __hip_atomic_fetch_add(ssw + row, ss_fix(qw), __ATOMIC_RELAXED, __HIP_MEMORY_SCOPE_AGENT);
                }
            }
    }
};
struct EpiWin {
    static constexpr bool PERM = true, AFTER_DRAIN = false;
    bf16* P; const u64* ss; const f32x2* rot; const float* qg; const float* kg;
    __device__ __forceinline__ void operator()(const f32x4 (&acc)[2][2][4][2], const pg8::Unit& u, int wr, int wc, int fr, int fq) const {
        const int type = u.pn >> 1;
        const int row0 = u.pm * 256 + wr * 64 + fr, cbase = u.pn * 256;
        if (type <= 1) {
            const int hh = wc >> 1, j0 = 32 * (wc & 1) + 8 * fq;
#pragma unroll
            for (int ai = 0; ai < 2; ++ai)
#pragma unroll
                for (int m = 0; m < 4; ++m) {
                    const int row = row0 + ai * 128 + m * 16;
                    const float s = ss_scale(ss, row);
                    const f32x4* rp = (const f32x4*)(rot + (size_t)(row & (SEQ - 1)) * 64 + j0);
                    float o1[8], o2[8];
#pragma unroll
                    for (int n = 0; n < 2; ++n) {
                        const f32x4 cs0 = rp[2 * n], cs1 = rp[2 * n + 1];
                        const float cc[4] = {cs0[0], cs0[2], cs1[0], cs1[2]}, sn[4] = {cs0[1], cs0[3], cs1[1], cs1[3]};
#pragma unroll
                        for (int i = 0; i < 4; ++i) { const float x1 = acc[ai][0][m][n][i] * s, x2 = acc[ai][1][m][n][i] * s; o1[4 * n + i] = x1 * cc[i] - x2 * sn[i]; o2[4 * n + i] = x1 * sn[i] + x2 * cc[i]; }
                    }
                    bf16* op = P + (size_t)row * NIN + cbase + hh * 128 + j0;
                    u32x4 w; w.x = pkbf(o1[0], o1[1]); w.y = pkbf(o1[2], o1[3]); w.z = pkbf(o1[4], o1[5]); w.w = pkbf(o1[6], o1[7]); *(u32x4*)op = w;
                    w.x = pkbf(o2[0], o2[1]); w.y = pkbf(o2[2], o2[3]); w.z = pkbf(o2[4], o2[5]); w.w = pkbf(o2[6], o2[7]); *(u32x4*)(op + 64) = w;
                }
        } else if (type == 4 || type == 5) {
            const int hh = wc >> 1, t = wc & 1; const float* gp = (type == 4 ? qg : kg) + t * 64 + 8 * fq; const float mul = (type == 4) ? C2 : 1.f;
            float gv[2][8];
#pragma unroll
            for (int bj = 0; bj < 2; ++bj)
#pragma unroll
                for (int i = 0; i < 8; ++i) gv[bj][i] = gp[bj * 32 + i] * mul;
#pragma unroll
            for (int ai = 0; ai < 2; ++ai)
#pragma unroll
                for (int m = 0; m < 4; ++m) {
                    const int row = row0 + ai * 128 + m * 16;
                    const float s = ss_scale(ss, row);
                    float v[2][8]; float q = 0.f;
#pragma unroll
                    for (int bj = 0; bj < 2; ++bj)
#pragma unroll
                        for (int n = 0; n < 2; ++n)
#pragma unroll
                            for (int i = 0; i < 4; ++i) { const float x = acc[ai][bj][m][n][i] * s; v[bj][4 * n + i] = x; q += x * x; }
                    q += __shfl_xor(q, 16); q += __shfl_xor(q, 32);
                    const float rs = __builtin_amdgcn_rsqf(q * (1.f / 64.f) + EPS);
                    bf16* op = P + (size_t)row * NIN + cbase + hh * 128 + t * 64 + 8 * fq;
#pragma unroll
                    for (int bj = 0; bj < 2; ++bj) {
                        u32x4 w; w.x = pkbf(v[bj][0] * rs * gv[bj][0], v[bj][1] * rs * gv[bj][1]); w.y = pkbf(v[bj][2] * rs * gv[bj][2], v[bj][3] * rs * gv[bj][3]);
                        w.z = pkbf(v[bj][4] * rs * gv[bj][4], v[bj][5] * rs * gv[bj][5]); w.w = pkbf(v[bj][6] * rs * gv[bj][6], v[bj][7] * rs * gv[bj][7]);
                        *(u32x4*)(op + bj * 32) = w;
                    }
                }
        } else {
            const bool act = (type == 3);
#pragma unroll
            for (int ai = 0; ai < 2; ++ai)
#pragma unroll
                for (int m = 0; m < 4; ++m) {
                    const int row = row0 + ai * 128 + m * 16;
                    const float s = ss_scale(ss, row);
                    bf16* op = P + (size_t)row * NIN + cbase + wc * 32 + 8 * fq;
#pragma unroll
                    for (int bj = 0; bj < 2; ++bj) {
                        float v[8];
#pragma unroll
                        for (int n = 0; n < 2; ++n)
#pragma unroll
                            for (int i = 0; i < 4; ++i) { const float x = acc[ai][bj][m][n][i] * s; v[4 * n + i] = act ? silu_f(x) : x; }
                        u32x4 w; w.x = pkbf(v[0], v[1]); w.y = pkbf(v[2], v[3]); w.z = pkbf(v[4], v[5]); w.w = pkbf(v[6], v[7]);
                        *(u32x4*)(op + bj * 128) = w;
                    }
                }
        }
    }
};

__device__ __forceinline__ void tr_item(const float* W, int ldw, int K, int k0, int srccol0, bf16* WT, int dstrow0, const float* gain, float scale, LAS float* scr, int lane, const float* gain2 = nullptr) {
#pragma unroll
    for (int i = 0; i < 32; ++i) { const int kk = 2 * i + (lane >> 5); float gsc = gain ? gain[k0 + kk] * scale : scale; if (gain2) gsc *= gain2[k0 + kk]; scr[kk * 33 + (lane & 31)] = W[(size_t)(k0 + kk) * ldw + srccol0 + (lane & 31)] * gsc; }
    LDS_WAIT();
    const int c = lane & 7;
#pragma unroll
    for (int j = 0; j < 4; ++j) { const int n = (lane >> 3) + 8 * j; const LAS float* s = scr + (8 * c) * 33 + n;
        u32x4 o; o.x = pkbf(s[0 * 33], s[1 * 33]); o.y = pkbf(s[2 * 33], s[3 * 33]); o.z = pkbf(s[4 * 33], s[5 * 33]); o.w = pkbf(s[6 * 33], s[7 * 33]);
        *(u32x4*)(WT + (size_t)(dstrow0 + n) * K + k0 + 8 * c) = o; }
    LDS_WAIT();
}
__device__ __forceinline__ void phase_prep(const Args& a, unsigned char* ws, LAS unsigned char* lds, int vcu, int G, int tid, int wid, int lane) {
    LAS float* scr = (LAS float*)(lds + wid * 16384);
    const int gw = vcu * 8 + wid, NGW = G * 8;
    constexpr int I_GU = 16 * 176, I_D = 44 * 32, I_IN = 16 * 112, I_OUT = 16 * 32, I_L = 2 * I_GU + 2 * I_D + I_IN + I_OUT;
    for (int it = gw; it < 2 * I_L; it += NGW) {
        const int l = it / I_L; int r = it % I_L;
        unsigned char* wl = ws + WS_W + (size_t)l * W_LAYER;
        if (r < I_GU || (r >= I_GU + I_D + I_IN + I_OUT && r < 2 * I_GU + I_D + I_IN + I_OUT)) {
            const bool second = r >= I_GU; if (second) r -= I_GU + I_D + I_IN + I_OUT;
            const int kb = r / 176, nb = r % 176, n0 = nb * 32, pn = n0 >> 8, half = (n0 >> 7) & 1, j0 = n0 & 127;
            const float* src = a.in[second ? (half ? 18 : 17) : (half ? 4 : 3)] + (size_t)l * DM * FF;
            tr_item(src, FF, DM, kb * 64, pn * 128 + j0, (bf16*)(wl + (second ? WO_GU2 : WO_GU1)), n0, a.in[second ? 16 : 2] + l * DM, 1.f, scr, lane, (!second && l > 0) ? a.in[20] + (l - 1) * DM : nullptr);
            continue;
        }
        r -= I_GU;
        if (r < I_D) { const int kb = r / 32, nb = r % 32; tr_item(a.in[5] + (size_t)l * FF * DM, DM, FF, kb * 64, nb * 32, (bf16*)(wl + WO_D1), nb * 32, nullptr, 0.5f, scr, lane); continue; }
        r -= I_D;
        if (r < I_IN) {
            const int kb = r / 112, nb = r % 112, n0 = nb * 32, pn = n0 >> 8, w = n0 & 255, bj = w >> 7, q0 = w & 127, type = pn >> 1;
            int src;
            if (type <= 1) src = pn * 256 + (q0 >> 6) * 128 + bj * 64 + (q0 & 63);
            else if (type == 4 || type == 5) { const int wc = q0 >> 5; src = pn * 256 + (wc >> 1) * 128 + (wc & 1) * 64 + bj * 32; }
            else src = n0;
            tr_item(a.in[7] + (size_t)l * DM * NIN, NIN, DM, kb * 64, src, (bf16*)(wl + WO_IN), n0, a.in[6] + l * DM, type == 1 ? 0.08838834764831845f : 1.f, scr, lane);
            continue;
        }
        r -= I_IN;
        if (r < I_OUT) { const int kb = r / 32, nb = r % 32; tr_item(a.in[15] + (size_t)l * DM * DM, DM, DM, kb * 64, nb * 32, (bf16*)(wl + WO_OUT), nb * 32, nullptr, 1.f, scr, lane); continue; }
        r -= I_OUT + I_GU;
        { const int kb = r / 32, nb = r % 32; tr_item(a.in[19] + (size_t)l * FF * DM, DM, FF, kb * 64, nb * 32, (bf16*)(wl + WO_D2), nb * 32, nullptr, 0.5f, scr, lane); }
    }
    u64* stat = (u64*)(ws + WS_STAT); bf16* hb = (bf16*)(ws + WS_HB);
    for (int row0 = gw; row0 < T; row0 += 4 * NGW) {
        f32x4 v[4][4]; float sq[4];
#pragma unroll
        for (int k = 0; k < 4; ++k) {
            const int row = row0 + k * NGW;
            if (row < T) {
                const float* xr = (row < TP) ? a.in[0] + (size_t)row * DM : a.in[1] + (size_t)(row - TP) * DM;
#pragma unroll
                for (int j = 0; j < 4; ++j) v[k][j] = ((const f32x4*)xr)[lane + 64 * j];
            }
        }
#pragma unroll
        for (int k = 0; k < 4; ++k) {
            const int row = row0 + k * NGW;
            if (row < T) {
                float s = 0.f;
#pragma unroll
                for (int j = 0; j < 4; ++j) s += (v[k][j][0] * v[k][j][0] + v[k][j][1] * v[k][j][1]) + (v[k][j][2] * v[k][j][2] + v[k][j][3] * v[k][j][3]);
                sq[k] = wave_sum(s);
                if (lane == 0) stat[row] = ss_fix(sq[k]);
#pragma unroll
                for (int j = 0; j < 4; ++j) { u32x2 w; w.x = pkbf(v[k][j][0], v[k][j][1]); w.y = pkbf(v[k][j][2], v[k][j][3]); *(u32x2*)(hb + (size_t)row * DM + 4 * (lane + 64 * j)) = w; }
            }
        }
    }
    const int gt = vcu * 512 + tid, NT = G * 512;
    for (int i = gt; i < T; i += NT) { stat[1 * T + i] = 0; stat[2 * T + i] = 0; stat[3 * T + i] = 0; stat[4 * T + i] = 0; stat[5 * T + i] = 0; stat[6 * T + i] = 0; stat[7 * T + i] = 0; }
    f32x2* rot = (f32x2*)(ws + WS_ROT);
    for (int i = gt; i < SEQ * 64; i += NT) {
        const int pos = i >> 6, j = i & 63;
        const float inv = exp2f((float)(-j) * 0.20762050593046015f);
        const float ang = (float)pos * inv;
        const float fr = fmaf(ang, 0.15915494309189535f, -rintf(ang * 0.15915494309189535f));
        rot[i] = (f32x2){__builtin_amdgcn_cosf(fr), __builtin_amdgcn_sinf(fr)};
    }
}

__device__ __forceinline__ void phase_fnorm(const Args& a, unsigned char* ws, float* outp, int l, int vcu, int G, int wid, int lane) {
    const int gw = vcu * 8 + wid, NGW = G * 8;
    u64* stat = (u64*)(ws + WS_STAT); bf16* hb = (bf16*)(ws + WS_HB);
    const f32x4* gp = (const f32x4*)(a.in[20] + l * DM);
    f32x4 g[4];
#pragma unroll
    for (int j = 0; j < 4; ++j) g[j] = gp[lane + 64 * j];
    for (int row0 = gw; row0 < T; row0 += 2 * NGW) {
        f32x4 v[2][4]; float sc[2];
#pragma unroll
        for (int k = 0; k < 2; ++k) {
            const int row = row0 + k * NGW;
            if (row < T) {
                const bf16* hr = hb + (size_t)row * DM;
#pragma unroll
                for (int j = 0; j < 4; ++j) { const u32x2 w = *(const u32x2*)(hr + 4 * (lane + 64 * j)); v[k][j] = (f32x4){bflo(w.x), bfhi(w.x), bflo(w.y), bfhi(w.y)}; }
                sc[k] = ss_scale(stat + (size_t)(l * 4 + 3) * T, row);
            }
        }
#pragma unroll
        for (int k = 0; k < 2; ++k) {
            const int row = row0 + k * NGW;
            if (row < T) {
                float* hr = outp + (size_t)row * DM; float q = 0.f;
#pragma unroll
                for (int j = 0; j < 4; ++j) {
                    const f32x4 x = v[k][j] * sc[k] * g[j];
                    ((f32x4*)hr)[lane + 64 * j] = x; q += (x[0] * x[0] + x[1] * x[1]) + (x[2] * x[2] + x[3] * x[3]);
                    if (l == 0) { u32x2 w; w.x = pkbf(x[0], x[1]); w.y = pkbf(x[2], x[3]); *(u32x2*)(hb + (size_t)row * DM + 4 * (lane + 64 * j)) = w; }
                }
                if (l == 0) { q = wave_sum(q); if (lane == 0) stat[4 * T + row] = ss_fix(q); }
            }
        }
    }
}

__device__ __forceinline__ void ret_gammas(const Args& a, int l, int h, float& lgf2, float& lgb2) {
    const float xf = a.in[8][(l * 2 + 0) * 4 + h], xb = a.in[8][(l * 2 + 1) * 4 + h];
    lgf2 = -log1pf(expf(-xf)) * LOG2E; lgb2 = -log1pf(expf(-xb)) * LOG2E;
}
__device__ __forceinline__ void r1_unit(const Args& a, unsigned char* ws, bf16* STB, LAS unsigned char* lds, int l, int unit, int tid, int wid, int lane) {
    asm volatile("" : "+v"(lane), "+v"(tid));
    const int n = unit & 15, h = (unit >> 4) & 3, b = unit >> 6;
    float lgf2, lgb2; ret_gammas(a, l, h, lgf2, lgb2);
    const bf16* P = (const bf16*)(ws + WS_P);
    const bf16* kp = P + (size_t)(b * SEQ + n * 128) * NIN + 512 + h * 128;
    LAS unsigned char* KF = lds, * KB = lds + 32768, * VT = lds + 65536;
#pragma unroll
    for (int i = 0; i < 4; ++i) {
        const int c = tid + 512 * i, row = c >> 4, ch = c & 15;
        const u32x4 kv = *(const u32x4*)(kp + (size_t)row * NIN + ch * 8), vv = *(const u32x4*)(kp + 512 + (size_t)row * NIN + ch * 8);
        const float zf = __builtin_amdgcn_exp2f((float)(127 - row) * lgf2), zb = __builtin_amdgcn_exp2f((float)row * lgb2);
        u32x4 wf, wb;
#pragma unroll
        for (int e = 0; e < 4; ++e) { const float x0 = bflo(kv[e]), x1 = bfhi(kv[e]); wf[e] = pkbf(x0 * zf, x1 * zf); wb[e] = pkbf(x0 * zb, x1 * zb); }
        const unsigned o = offb(row, ch);
        *(LAS u32x4*)(KF + o) = wf; *(LAS u32x4*)(KB + o) = wb; *(LAS u32x4*)(VT + o) = vv;
    }
    __syncthreads();
    const int r32 = lane & 31, hi = lane >> 5, g1 = (lane >> 4) & 1, q4 = (lane & 15) >> 2, p4 = lane & 3;
    const int dir = wid >> 2, db = wid & 3;
    const LAS unsigned char* KS = dir ? KB : KF;
    f32x16 acc[4];
#pragma unroll
    for (int eb = 0; eb < 4; ++eb)
#pragma unroll
        for (int r = 0; r < 16; ++r) acc[eb][r] = 0.f;
    unsigned vbn[4][2];
#pragma unroll
    for (int c = 0; c < 4; ++c) { vbn[c][0] = tr_base_nat(c, 0, lane); vbn[c][1] = tr_base_nat(c, 1, lane); }
    const unsigned kb0 = tr_base_nat(db, 0, lane), kb1 = tr_base_nat(db, 1, lane);
#pragma unroll
    for (int ks = 0; ks < 8; ++ks) {
        const bf16x8 bfr = tr_pair(KS + kb0 + 256 * (16 * ks), KS + kb1 + 256 * (16 * ks + 4));
#pragma unroll
        for (int eb = 0; eb < 4; ++eb) { const bf16x8 afr = tr_pair(VT + vbn[eb][0] + 256 * (16 * ks), VT + vbn[eb][1] + 256 * (16 * ks + 4)); acc[eb] = __builtin_amdgcn_mfma_f32_32x32x16_bf16(afr, bfr, acc[eb], 0, 0, 0); }
    }
    bf16* st = STB + ((size_t)(((b * 4 + h) * 16 + n) * 2 + dir)) * 16384 + (size_t)(32 * db + r32) * 128;
#pragma unroll
    for (int eb = 0; eb < 4; ++eb)
#pragma unroll
        for (int pr = 0; pr < 2; ++pr) {
            const unsigned ax = pkbf(acc[eb][8 * pr], acc[eb][8 * pr + 1]), ay = pkbf(acc[eb][8 * pr + 2], acc[eb][8 * pr + 3]), bx = pkbf(acc[eb][8 * pr + 4], acc[eb][8 * pr + 5]), by = pkbf(acc[eb][8 * pr + 6], acc[eb][8 * pr + 7]);
            const auto sx = __builtin_amdgcn_permlane32_swap(ax, bx, false, false), sy = __builtin_amdgcn_permlane32_swap(ay, by, false, false);
            u32x4 w; w.x = sx[0]; w.y = sy[0]; w.z = sx[1]; w.w = sy[1];
            *(u32x4*)(st + 32 * eb + 16 * pr + 8 * hi) = w; }
    __syncthreads();
}
__device__ __forceinline__ void phase_scan(const Args& a, unsigned char* ws, bf16* STB, int l, int vcu, int G, int tid, int z) {
    bf16* ST = STB;
    const int gt = vcu * 512 + tid, NT = G * 512;
    for (int it = gt; it < 192 * 2 * 2048; it += NT) {
        const int grp = it & 2047, dir = (it >> 11) & 1, bh = it >> 12, h = bh & 3;
        float lgf2, lgb2; ret_gammas(a, l, h, lgf2, lgb2);
        const float g = __builtin_amdgcn_exp2f(128.f * (dir ? lgb2 : lgf2));
        bf16* base = ST + ((size_t)(bh * 16) * 2 + dir) * 16384 + grp * 8;
        u32x4 kv[16];
        const size_t cst = (size_t)(32768 + z);
#pragma unroll
        for (int n = 0; n < 16; ++n) kv[n] = *(const u32x4*)(base + (size_t)n * cst);
        float c[8];
#pragma unroll
        for (int e = 0; e < 8; ++e) c[e] = 0.f;
#pragma unroll
        for (int i = 0; i < 16; ++i) {
            const int n = dir ? 15 - i : i;
            u32x4 w; w.x = pkbf(c[0], c[1]); w.y = pkbf(c[2], c[3]); w.z = pkbf(c[4], c[5]); w.w = pkbf(c[6], c[7]);
            *(u32x4*)(base + (size_t)n * cst) = w;
#pragma unroll
            for (int e = 0; e < 4; ++e) { c[2 * e] = bflo(kv[n][e]) + g * c[2 * e]; c[2 * e + 1] = bfhi(kv[n][e]) + g * c[2 * e + 1]; }
        }
    }
}
__device__ __forceinline__ void r2_unit(const Args& a, unsigned char* ws, bf16* STB, LAS unsigned char* lds, int l, int unit, int tid, int wid, int lane, int dry) {
    asm volatile("" : "+v"(lane), "+v"(tid));
    const int n = unit & 15, h = (unit >> 4) & 3, b = unit >> 6;
    float lgf2, lgb2; ret_gammas(a, l, h, lgf2, lgb2);
    bf16* P = (bf16*)(ws + WS_P);
    const bf16* kp = P + (size_t)(b * SEQ + n * 128) * NIN + 512 + h * 128;
    const bf16* sp = STB + ((size_t)((b * 4 + h) * 16 + n) * 2) * 16384;
    LAS unsigned char* KT = lds, * VT = lds + 32768, * SF = lds + 65536, * SB = lds + 98304;
#pragma unroll
    for (int i = 0; i < 4; ++i) {
        const int c = tid + 512 * i, row = c >> 4, ch = c & 15; const unsigned o = offb(row, ch);
        const u32x4 kv = *(const u32x4*)(kp + (size_t)row * NIN + ch * 8), vv = *(const u32x4*)(kp + 512 + (size_t)row * NIN + ch * 8);
        const u32x4 sf = *(const u32x4*)(sp + row * 128 + ch * 8), sb = *(const u32x4*)(sp + 16384 + row * 128 + ch * 8);
        *(LAS u32x4*)(KT + o) = kv; *(LAS u32x4*)(VT + o) = vv; *(LAS u32x4*)(SF + o) = sf; *(LAS u32x4*)(SB + o) = sb;
    }
    const int r32 = lane & 31, hi = lane >> 5, g1 = (lane >> 4) & 1, q4 = (lane & 15) >> 2, p4 = lane & 3;
    const int cb = wid & 3, eh = wid >> 2;
    const int cl = 32 * cb + r32;
    const size_t tok = (size_t)b * SEQ + n * 128 + cl;
    bf16x8 qf[8];
#pragma unroll
    for (int kd = 0; kd < 8; ++kd) qf[kd] = *(const bf16x8*)(P + tok * NIN + h * 128 + 16 * kd + 8 * hi);
    __syncthreads();
    f32x16 O[2], XF[2], XB[2];
#pragma unroll
    for (int e = 0; e < 2; ++e)
#pragma unroll
        for (int r = 0; r < 16; ++r) { O[e][r] = 0.f; XF[e][r] = 0.f; XB[e][r] = 0.f; }
    float ff[16], fb[16];
#pragma unroll
    for (int r = 0; r < 16; ++r) { ff[r] = __builtin_amdgcn_exp2f((float)(31 - crow(r, hi)) * lgf2); fb[r] = __builtin_amdgcn_exp2f((float)crow(r, hi) * lgb2); }
    unsigned vp[2][2], sn[2][2], kb[8];
#pragma unroll
    for (int e = 0; e < 2; ++e)
#pragma unroll
        for (int tt = 0; tt < 2; ++tt) { vp[e][tt] = tr_base_perm(2 * eh + e, tt, lane); sn[e][tt] = tr_base_nat(2 * eh + e, tt, lane); }
#pragma unroll
    for (int kd = 0; kd < 8; ++kd) kb[kd] = row_base(2 * kd, lane);
#pragma unroll
    for (int mb = 0; mb < 4; ++mb) {
        f32x16 S;
#pragma unroll
        for (int r = 0; r < 16; ++r) S[r] = 0.f;
#pragma unroll
        for (int kd = 0; kd < 8; ++kd) { const bf16x8 kf = *(const LAS bf16x8*)(KT + kb[kd] + 8192 * mb); S = __builtin_amdgcn_mfma_f32_32x32x16_bf16(kf, qf[kd], S, 0, 0, 0); }
        if (mb < cb) { const float fa = __builtin_amdgcn_exp2f((float)(cl - 32 * mb - 31) * lgf2);
#pragma unroll
            for (int r = 0; r < 16; ++r) S[r] *= fa * ff[r];
        } else if (mb > cb) { const float fa = __builtin_amdgcn_exp2f((float)(32 * mb - cl) * lgb2);
#pragma unroll
            for (int r = 0; r < 16; ++r) S[r] *= fa * fb[r];
        } else {
#pragma unroll
            for (int r = 0; r < 16; ++r) { const int rel = r32 - crow(r, hi); const float d = (rel >= 0) ? (float)rel * lgf2 : (float)(-rel) * lgb2; S[r] *= __builtin_amdgcn_exp2f(d); }
        }
#pragma unroll
        for (int s = 0; s < 2; ++s) {
            const bf16x8 pk = pack8(S, s);
#pragma unroll
            for (int e = 0; e < 2; ++e) { const bf16x8 vf = tr_pair(VT + vp[e][0] + 256 * (32 * mb + 16 * s), VT + vp[e][1] + 256 * (32 * mb + 16 * s + 8)); O[e] = __builtin_amdgcn_mfma_f32_32x32x16_bf16(vf, pk, O[e], 0, 0, 0); }
        }
    }
#pragma unroll
    for (int kd = 0; kd < 8; ++kd) {
#pragma unroll
        for (int e = 0; e < 2; ++e) {
            const bf16x8 ff = tr_pair(SF + sn[e][0] + 256 * (16 * kd), SF + sn[e][1] + 256 * (16 * kd + 4)); XF[e] = __builtin_amdgcn_mfma_f32_32x32x16_bf16(ff, qf[kd], XF[e], 0, 0, 0);
            const bf16x8 fb = tr_pair(SB + sn[e][0] + 256 * (16 * kd), SB + sn[e][1] + 256 * (16 * kd + 4)); XB[e] = __builtin_amdgcn_mfma_f32_32x32x16_bf16(fb, qf[kd], XB[e], 0, 0, 0);
        }
    }
    const float xf = __builtin_amdgcn_exp2f((float)(cl + 1) * lgf2), xb = __builtin_amdgcn_exp2f((float)(128 - cl) * lgb2);
    float s1 = 0.f, s2 = 0.f;
#pragma unroll
    for (int e = 0; e < 2; ++e)
#pragma unroll
        for (int r = 0; r < 16; ++r) { const float o = O[e][r] + xf * XF[e][r] + xb * XB[e][r]; O[e][r] = o; s1 += o; s2 += o * o; }
    s1 += __shfl_xor(s1, 32); s2 += __shfl_xor(s2, 32);
    LAS f32x2* stt = (LAS f32x2*)(lds + LDS_STATS);
    if (hi == 0) stt[eh * 128 + cl] = (f32x2){s1, s2};
    __syncthreads();
    const f32x2 o2 = stt[(eh ^ 1) * 128 + cl];
    const float mu = (s1 + o2[0]) * (1.f / 128.f), var = (s2 + o2[1]) * (1.f / 128.f) - mu * mu, rstd = __builtin_amdgcn_rsqf(fmaxf(var, 0.f) + EPS);
    const float* gg = a.in[9] + l * 512 + h * 128;
    bf16* gp = P + tok * NIN + 1536 + h * 128;
#pragma unroll
    for (int e = 0; e < 2; ++e)
#pragma unroll
        for (int pr = 0; pr < 2; ++pr) {
            unsigned wv[2][2];
#pragma unroll
            for (int k = 0; k < 2; ++k) {
                const int rq = 2 * pr + k, e0 = 64 * eh + 32 * e + 8 * rq + 4 * hi;
                const u32x2 sg = *(const u32x2*)(gp + e0); const f32x4 gv = *(const f32x4*)(gg + e0);
                const float y0 = (O[e][4 * rq + 0] - mu) * rstd * gv[0] * bflo(sg.x), y1 = (O[e][4 * rq + 1] - mu) * rstd * gv[1] * bfhi(sg.x);
                const float y2 = (O[e][4 * rq + 2] - mu) * rstd * gv[2] * bflo(sg.y), y3 = (O[e][4 * rq + 3] - mu) * rstd * gv[3] * bfhi(sg.y);
                wv[k][0] = pkbf(y0, y1); wv[k][1] = pkbf(y2, y3);
            }
            const auto sx = __builtin_amdgcn_permlane32_swap(wv[0][0], wv[1][0], false, false), sy = __builtin_amdgcn_permlane32_swap(wv[0][1], wv[1][1], false, false);
            u32x4 w; w.x = sx[0]; w.y = sy[0]; w.z = sx[1]; w.w = sy[1];
            if (!dry) *(u32x4*)(gp + 64 * eh + 32 * e + 16 * pr + 8 * hi) = w;
        }
    __syncthreads();
}

__device__ __forceinline__ void dattn_setup(const Args& a, LAS unsigned char* lds, int l, int tid, int lane) {
    const float* qg = a.in[10] + l * 128, * kg = a.in[11] + l * 128, * tb = a.in[14], * lv = a.in[12] + l * 256;
    const float mq = wave_max(fmaxf(fabsf(qg[lane]), fabsf(qg[64 + lane]))), mk = wave_max(fmaxf(fabsf(kg[lane]), fabsf(kg[64 + lane])));
    const float mb = wave_max(fmaxf(tb[lane], tb[64 + lane]));
    const float M = 8.f * mq * mk + mb;
    const float s0 = wave_sum(lv[lane] * lv[64 + lane]), s1 = wave_sum(lv[128 + lane] * lv[192 + lane]);
    const float lam_init = 0.8f - 0.6f * expf(-0.3f * (float)l);
    const float lam = expf(s0) - expf(s1) + lam_init;
    LAS float* tab = (LAS float*)(lds + LDS_TAB); LAS float* misc = (LAS float*)(lds + LDS_MISC);
    for (int i = tid; i < 4 * 321; i += 512) { const int h = i / 321, k = i % 321; tab[i] = (tb[rel_bucket(k - 160) * 4 + h] - M) * LOG2E; }
    if (tid == 0) { misc[0] = lam; misc[1] = 1.f - lam_init; }
    __syncthreads();
}
#define DA_LOAD(kt) do { _Pragma("unroll") for (int i_ = 0; i_ < 2; ++i_) { const int c_ = tid + 512 * i_, row_ = c_ >> 4, ch_ = c_ & 15; \
        kr[i_] = *(const u32x4*)(kbase + (size_t)((kt) * 64 + row_) * NIN + ch_ * 8); vr[i_] = *(const u32x4*)(kbase + 512 + (size_t)((kt) * 64 + row_) * NIN + ch_ * 8); } } while (0)
#define DA_STORE(buf) do { _Pragma("unroll") for (int i_ = 0; i_ < 2; ++i_) { const int c_ = tid + 512 * i_, row_ = c_ >> 4, ch_ = c_ & 15; const unsigned o_ = offb(row_, ch_); \
        *(LAS u32x4*)(lds + (buf) * 32768 + o_) = kr[i_]; *(LAS u32x4*)(lds + (buf) * 32768 + 16384 + o_) = vr[i_]; } } while (0)
__device__ __forceinline__ void dattn_unit(const Args& a, unsigned char* ws, LAS unsigned char* lds, int l, int unit, int tid, int wid, int lane, int dry) {
    asm volatile("" : "+v"(lane), "+v"(tid));
    const int qb = unit & 15, h = (unit >> 4) & 3, b = unit >> 6;
    const int r32 = lane & 31, hi = lane >> 5, g1 = (lane >> 4) & 1, q4 = (lane & 15) >> 2, p4 = lane & 3;
    const int t = wid & 1, rg = wid >> 1;
    const int qw = qb * 128 + rg * 32;
    bf16* P = (bf16*)(ws + WS_P);
    const size_t tok = (size_t)b * SEQ + qw + r32;
    const LAS float* tab = (const LAS float*)(lds + LDS_TAB) + h * 321;
    const LAS float* misc = (const LAS float*)(lds + LDS_MISC);
    bf16x8 qf[4];
#pragma unroll
    for (int d0 = 0; d0 < 4; ++d0) qf[d0] = *(const bf16x8*)(P + tok * NIN + 2048 + h * 128 + t * 64 + 16 * d0 + 8 * hi);
    const bf16* kbase = P + (size_t)b * SEQ * NIN + 2560 + h * 128;
    f32x16 O[4];
#pragma unroll
    for (int eb = 0; eb < 4; ++eb)
#pragma unroll
        for (int r = 0; r < 16; ++r) O[eb][r] = 0.f;
    float lsum = 0.f;
    const float bneg = tab[0], bpos = tab[320];
    unsigned vp[4][2], kb[4];
#pragma unroll
    for (int c = 0; c < 4; ++c) { vp[c][0] = tr_base_perm(c, 0, lane); vp[c][1] = tr_base_perm(c, 1, lane); kb[c] = row_base(8 * t + 2 * c, lane); }
    const int rot = 2 * qb;
    int dsrc[2];
#pragma unroll
    for (int i = 0; i < 2; ++i) { const int p = (2 * wid + i) * 64 + lane, row = p >> 4, ch = (p & 15) ^ (((row & 3) << 2) | ((row >> 2) & 3)); dsrc[i] = row * NIN + ch * 8; }
#define DA_DMAK(kt, slot) do { _Pragma("unroll") for (int i_ = 0; i_ < 2; ++i_) __builtin_amdgcn_global_load_lds((const unsigned*)(kbase + (size_t)((((kt) + rot) & 31) * 64) * NIN + dsrc[i_]), \
        (LAS unsigned*)(lds + (slot) * 32768 + (2 * wid + i_) * 1024), 16, 0, 0); } while (0)
#define DA_DMAV(kt, slot) do { _Pragma("unroll") for (int i_ = 0; i_ < 2; ++i_) __builtin_amdgcn_global_load_lds((const unsigned*)(kbase + 512 + (size_t)((((kt) + rot) & 31) * 64) * NIN + dsrc[i_]), \
        (LAS unsigned*)(lds + (slot) * 32768 + 16384 + (2 * wid + i_) * 1024), 16, 0, 0); } while (0)
#define DA_WAITBAR() asm volatile("s_waitcnt vmcnt(0) lgkmcnt(0)\n\ts_barrier" ::: "memory")
#define DA_QK(kt, slot, SN) do { \
        const LAS unsigned char* KT_ = lds + (slot) * 32768; \
        bf16x8 kf_[2][4]; \
        _Pragma("unroll") for (int blk = 0; blk < 2; ++blk) _Pragma("unroll") for (int d0 = 0; d0 < 4; ++d0) kf_[blk][d0] = *(const LAS bf16x8*)(KT_ + kb[d0] + 8192 * blk); \
        _Pragma("unroll") for (int blk = 0; blk < 2; ++blk) { \
            const int k0_ = (((kt) + rot) & 31) * 64 + blk * 32, relmax_ = k0_ + 31 - qw, relmin_ = k0_ - qw - 31; \
            const float cinit_ = (relmax_ <= -91) ? bneg : ((relmin_ >= 91) ? bpos : 0.f); \
            _Pragma("unroll") for (int r = 0; r < 16; ++r) SN[blk][r] = cinit_; \
            _Pragma("unroll") for (int d0 = 0; d0 < 4; ++d0) SN[blk] = __builtin_amdgcn_mfma_f32_32x32x16_bf16(kf_[blk][d0], qf[d0], SN[blk], 0, 0, 0); \
        } } while (0)
#define DA_SB() __builtin_amdgcn_sched_barrier(0)
#define DA_VRD(blk, j) tr_pair(VT_ + vp[(j) & 3][0] + 256 * (32 * (blk) + 16 * ((j) >> 2)), VT_ + vp[(j) & 3][1] + 256 * (32 * (blk) + 16 * ((j) >> 2) + 8))
#define DA_STEP(kt, par, SC, SN, HAS_K2, HAS_V1, HAS_QK) do { \
        if (HAS_K2) DA_DMAK((kt) + 2, par); \
        if (HAS_V1) DA_DMAV((kt) + 1, (par) ^ 1); \
        const LAS unsigned char* KT_ = lds + ((par) ^ 1) * 32768; const LAS unsigned char* VT_ = lds + (par) * 32768 + 16384; \
        bf16x8 kf_[2][4], vf_[8]; \
        if (HAS_QK) { \
            _Pragma("unroll") for (int blk = 0; blk < 2; ++blk) _Pragma("unroll") for (int d0 = 0; d0 < 4; ++d0) kf_[blk][d0] = *(const LAS bf16x8*)(KT_ + kb[d0] + 8192 * blk); \
            _Pragma("unroll") for (int blk = 0; blk < 2; ++blk) { \
                const int k0_ = (((kt) + 1 + rot) & 31) * 64 + blk * 32, relmax_ = k0_ + 31 - qw, relmin_ = k0_ - qw - 31; \
                const float cinit_ = (relmax_ <= -91) ? bneg : ((relmin_ >= 91) ? bpos : 0.f); \
                _Pragma("unroll") for (int r = 0; r < 16; ++r) SN[blk][r] = cinit_; } \
        } \
        _Pragma("unroll") for (int blk = 0; blk < 2; ++blk) { \
            const int k0_ = (((kt) + rot) & 31) * 64 + blk * 32, relmax_ = k0_ + 31 - qw, relmin_ = k0_ - qw - 31; \
            if (!(relmax_ <= -91 || relmin_ >= 91)) { \
                const LAS float* tb_ = tab + (k0_ - qw - r32 + 4 * hi + 160);     \
                _Pragma("unroll") for (int r = 0; r < 16; ++r) SC[blk][r] += tb_[(r & 3) + 8 * (r >> 2)]; \
            } } \
        DA_SB(); \
        _Pragma("unroll") for (int j = 0; j < 8; ++j) { \
            if (HAS_QK) SN[j >> 2] = __builtin_amdgcn_mfma_f32_32x32x16_bf16(kf_[j >> 2][j & 3], qf[j & 3], SN[j >> 2], 0, 0, 0); \
            SC[0][2 * j] = __builtin_amdgcn_exp2f(SC[0][2 * j]); SC[0][2 * j + 1] = __builtin_amdgcn_exp2f(SC[0][2 * j + 1]); \
            vf_[j] = DA_VRD(0, j); \
            DA_SB(); } \
        const bf16x8 pk00_ = pack8(SC[0], 0), pk01_ = pack8(SC[0], 1); \
        DA_SB(); \
        _Pragma("unroll") for (int j = 0; j < 8; ++j) { \
            O[j & 3] = __builtin_amdgcn_mfma_f32_32x32x16_bf16(vf_[j], (j >> 2) ? pk01_ : pk00_, O[j & 3], 0, 0, 0); \
            SC[1][2 * j] = __builtin_amdgcn_exp2f(SC[1][2 * j]); SC[1][2 * j + 1] = __builtin_amdgcn_exp2f(SC[1][2 * j + 1]); \
            lsum += SC[0][2 * j] + SC[0][2 * j + 1]; \
            vf_[j] = DA_VRD(1, j); \
            DA_SB(); } \
        const bf16x8 pk10_ = pack8(SC[1], 0), pk11_ = pack8(SC[1], 1); \
        DA_SB(); \
        __builtin_amdgcn_s_setprio(1);                            \
        _Pragma("unroll") for (int j = 0; j < 8; ++j) { \
            O[j & 3] = __builtin_amdgcn_mfma_f32_32x32x16_bf16(vf_[j], (j >> 2) ? pk11_ : pk10_, O[j & 3], 0, 0, 0); \
            lsum += SC[1][2 * j] + SC[1][2 * j + 1]; \
            DA_SB(); } \
        __builtin_amdgcn_s_setprio(0); \
        DA_WAITBAR(); } while (0)
    f32x16 SA[2], SB[2];
    DA_DMAK(0, 0); DA_DMAV(0, 0); DA_DMAK(1, 1);
    DA_WAITBAR();
    DA_QK(0, 0, SA);
    DA_WAITBAR();
    for (int kt = 0; kt < 30; kt += 2) { DA_STEP(kt, 0, SA, SB, true, true, true); DA_STEP(kt + 1, 1, SB, SA, true, true, true); }
    DA_STEP(30, 0, SA, SB, false, true, true);
    DA_STEP(31, 1, SB, SA, false, false, false);
#undef DA_SB
#undef DA_VRD
#undef DA_STEP
#undef DA_QK
#undef DA_DMAK
#undef DA_DMAV
#undef DA_WAITBAR
    lsum += __shfl_xor(lsum, 32);
    const float lam = misc[0], oneml = misc[1];
    LAS float* Y = (LAS float*)lds + rg * 4096;
    if (t == 1) {
        const float inv = lam / lsum;
#pragma unroll
        for (int eb = 0; eb < 4; ++eb)
#pragma unroll
            for (int r = 0; r < 16; ++r) Y[(32 * eb + crow(r, hi)) * 32 + r32] = O[eb][r] * inv;
    }
    __syncthreads();
    if (t == 0 && !dry) {
        const float inv = 1.f / lsum; float ssq = 0.f;
#pragma unroll
        for (int eb = 0; eb < 4; ++eb)
#pragma unroll
            for (int r = 0; r < 16; ++r) { const float o = O[eb][r] * inv - Y[(32 * eb + crow(r, hi)) * 32 + r32]; O[eb][r] = o; ssq += o * o; }
        ssq += __shfl_xor(ssq, 32);
        const float rs = __builtin_amdgcn_rsqf(ssq * (1.f / 128.f) + EPS) * oneml;
        const float* sg = a.in[13] + l * 128;
        bf16* op = P + tok * NIN + 2048 + h * 128;
#pragma unroll
        for (int eb = 0; eb < 4; ++eb)
#pragma unroll
            for (int pr = 0; pr < 2; ++pr) {
                u32x2 wa, wb;
                { const int rq = 2 * pr, e0 = 32 * eb + 8 * rq + 4 * hi; const f32x4 gv = *(const f32x4*)(sg + e0);
                  wa.x = pkbf(O[eb][4 * rq] * rs * gv[0], O[eb][4 * rq + 1] * rs * gv[1]); wa.y = pkbf(O[eb][4 * rq + 2] * rs * gv[2], O[eb][4 * rq + 3] * rs * gv[3]); }
                { const int rq = 2 * pr + 1, e0 = 32 * eb + 8 * rq + 4 * hi; const f32x4 gv = *(const f32x4*)(sg + e0);
                  wb.x = pkbf(O[eb][4 * rq] * rs * gv[0], O[eb][4 * rq + 1] * rs * gv[1]); wb.y = pkbf(O[eb][4 * rq + 2] * rs * gv[2], O[eb][4 * rq + 3] * rs * gv[3]); }
                const auto sx = __builtin_amdgcn_permlane32_swap(wa.x, wb.x, false, false), sy = __builtin_amdgcn_permlane32_swap(wa.y, wb.y, false, false);
                u32x4 w; w.x = sx[0]; w.y = sy[0]; w.z = sx[1]; w.w = sy[1];
                *(u32x4*)(op + 32 * eb + 16 * pr + 8 * hi) = w;
            }
    }
    __syncthreads();
}

#define XB_TMO      128
#define XB_XCNT(j)  (256  + 64 * (j))
#define XB_XSUB(j)  (1280 + 64 * (j))
#define XB_XGEN(j)  (2304 + 64 * (j))
#define XB_TOP      3328
#define XB_TOPGEN   3392
#define XCD_BAR_WORDS 3456
#define XB_SPIN_CAP (1u << 18)

__device__ __forceinline__ unsigned xb_ld(unsigned* p)              { return __hip_atomic_load(p, __ATOMIC_RELAXED, __HIP_MEMORY_SCOPE_AGENT); }
__device__ __forceinline__ unsigned xb_add(unsigned* p, unsigned v) { return __hip_atomic_fetch_add(p, v, __ATOMIC_RELAXED, __HIP_MEMORY_SCOPE_AGENT); }
__device__ __forceinline__ unsigned xb_xcc_id() { return (unsigned)__builtin_amdgcn_s_getreg((3 << 11) | 20) & 0xFu; }
#define XB_SPIN(cond, bar) do { unsigned _sp = 0; while (cond) { __builtin_amdgcn_s_sleep(1); \
    if ((++_sp & 255u) == 0u) { if (xb_ld(&(bar)[XB_TMO])) break; if (_sp > XB_SPIN_CAP) { atomicAdd(&(bar)[XB_TMO], 1u); break; } } } } while (0)

struct XcdBarrier {
    unsigned* bar; unsigned x;
    volatile LAS unsigned* st;
};

__device__ __forceinline__ XcdBarrier xcd_barrier_post(unsigned* bar, volatile LAS unsigned* st) {
    XcdBarrier b; b.bar = bar; b.x = xb_xcc_id(); b.st = st;
    if (threadIdx.x == 0) (void)xb_add(&bar[XB_XCNT(b.x)], 1u);
    return b;
}
__device__ __forceinline__ void xcd_barrier_complete(unsigned* bar, unsigned x, unsigned& nloc, unsigned& nx) {
    const unsigned G = gridDim.x * gridDim.y * gridDim.z;
    unsigned sum, cnt, mine, sp = 0u;
    for (;;) {
        sum = 0u; cnt = 0u; mine = 0u;
#pragma unroll
        for (unsigned j = 0; j < 16; ++j) { const unsigned c = xb_ld(&bar[XB_XCNT(j)]); sum += c; cnt += (c > 0u) ? 1u : 0u; mine = (j == x) ? c : mine; }
        if (sum == G) break;
        __builtin_amdgcn_s_sleep(1);
        if ((++sp & 255u) == 0u) { if (xb_ld(&bar[XB_TMO])) break; if (sp > XB_SPIN_CAP) { atomicAdd(&bar[XB_TMO], 1u); break; } }
    }
    nloc = mine > 0u ? mine : 1u; nx = cnt > 0u ? cnt : 1u;
}

__device__ __forceinline__ void xcd_barrier(const XcdBarrier& b) {
    asm volatile("s_waitcnt vmcnt(0)" ::: "memory");
    __syncthreads();
    if (threadIdx.x == 0) {
        unsigned* bar = b.bar;
        __builtin_amdgcn_s_waitcnt(0);
        unsigned nloc = b.st[0], nx = b.st[1];
        if (nloc == 0u) { xcd_barrier_complete(bar, b.x, nloc, nx); b.st[0] = nloc; b.st[1] = nx; }
        const unsigned old = xb_add(&bar[XB_XSUB(b.x)], 1u);
        const unsigned gen = old / nloc;
        if (old + 1u == (gen + 1u) * nloc) {
            __builtin_amdgcn_fence(__ATOMIC_RELEASE, "agent");
            asm volatile("s_waitcnt vmcnt(0)" ::: "memory");
            const unsigned og = xb_add(&bar[XB_TOP], 1u);
            const unsigned tg = og / nx;
            if (og + 1u == (tg + 1u) * nx) xb_add(&bar[XB_TOPGEN], 1u);
            else XB_SPIN(xb_ld(&bar[XB_TOPGEN]) == tg, bar);
            __builtin_amdgcn_fence(__ATOMIC_ACQUIRE, "agent");
            xb_add(&bar[XB_XGEN(b.x)], 1u);
            asm volatile("s_waitcnt vmcnt(0)" ::: "memory");
        } else {
            XB_SPIN(xb_ld(&bar[XB_XGEN(b.x)]) == gen, bar);
            __builtin_amdgcn_fence(__ATOMIC_ACQUIRE, "agent");
            asm volatile("s_waitcnt vmcnt(0)" ::: "memory");
        }
    }
    __syncthreads();
}

#ifndef PROBE_DUP
#define PROBE_DUP 0
#endif
template <int PHM, int PH> __device__ __forceinline__ void run_phase(const Args& a, LAS unsigned char* lds0, int dry) {
    int tid = threadIdx.x; asm volatile("" : "+v"(tid));
    const int lane = tid & 63, wid = __builtin_amdgcn_readfirstlane(tid >> 6);
    int z_; asm volatile("s_mov_b32 %0, 0" : "=s"(z_));
    unsigned char* ws = a.ws + z_;
    LAS unsigned char* lds = lds0 + z_;
    const int G = (int)gridDim.x + z_, bx = (int)blockIdx.x + z_;
    const int vcu = (G % 8 == 0) ? (bx % 8) * (G / 8) + bx / 8 : bx;
    float* outp = (float*)((unsigned char*)a.out + z_);
    u64* stat = (u64*)(ws + WS_STAT); bf16* hb = (bf16*)(ws + WS_HB); bf16* P = (bf16*)(ws + WS_P);
    if constexpr (PH == 0) { if constexpr ((PHM & 1) != 0) phase_prep(a, ws, lds, vcu, G, tid, wid, lane); }
    else {
        constexpr int l = (PH - 1) / 10, sp = (PH - 1) % 10;
        unsigned char* wl = ws + WS_W + (size_t)l * W_LAYER;
        if constexpr ((PHM & 2) != 0 && (sp == 0 || sp == 7)) {
            pg8::Gemm g{hb, (const bf16*)(wl + (sp == 0 ? WO_GU1 : WO_GU2)), T, 2 * FF, DM, DM};
            pg8::StaticOrder S; S.init(T, 2 * FF, G, bx);
            constexpr bool NN = (l > 0 && sp == 0);
            EpiSwiGLU<NN> E{P, stat + (size_t)(NN ? (l - 1) * 4 + 3 : l * 4 + (sp == 0 ? 0 : 2)) * T, stat + (size_t)(l * 4) * T};
            pg8::gemm_phase<EpiSwiGLU<NN>, pg8::StaticOrder, true, true>(lds, g, S, E, tid);
        } else if constexpr ((PHM & 4) != 0 && (sp == 1 || sp == 8 || sp == 6)) {
            pg8::Gemm g{sp == 6 ? P + 1536 : P, (const bf16*)(wl + (sp == 1 ? WO_D1 : (sp == 8 ? WO_D2 : WO_OUT))), T, DM, sp == 6 ? DM : FF, sp == 6 ? NIN : FF};
            pg8::StaticOrder S; S.init(T, DM, G, bx);
            constexpr int MODE = (sp == 8 && l + 1 < 2) ? 1 : ((sp == 1 && l > 0) ? 2 : 0);
            constexpr int lg = (MODE == 1) ? l : (l > 0 ? l - 1 : 0);
            constexpr bool WF32 = false;
            EpiRes<MODE, WF32> E{outp, hb, stat + (size_t)(l * 4 + (sp == 1 ? 1 : (sp == 6 ? 2 : 3))) * T, dry,
                           a.in[20] + lg * DM, stat + (size_t)(lg * 4 + 3) * T, stat + (size_t)((l + 1) * 4) * T};
            pg8::gemm_phase<EpiRes<MODE, WF32>, pg8::StaticOrder, true, true>(lds, g, S, E, tid);
        } else if constexpr ((PHM & 8) != 0 && sp == 2) {
            pg8::Gemm g{hb, (const bf16*)(wl + WO_IN), T, NIN, DM, DM};
            pg8::StaticOrder S; S.init(T, NIN, G, bx);
            EpiWin E{P, stat + (size_t)(l * 4 + 1) * T, (const f32x2*)(ws + WS_ROT), a.in[10] + l * 128, a.in[11] + l * 128};
            pg8::gemm_phase<EpiWin, pg8::StaticOrder, true, true>(lds, g, S, E, tid);
        } else if constexpr ((PHM & 16) != 0 && sp == 3) {
            for (int u = vcu; u < NB * 64; u += G) r1_unit(a, ws, (bf16*)outp, lds, l, u, tid, wid, lane);
        } else if constexpr ((PHM & 32) != 0 && sp == 4) {
            phase_scan(a, ws, (bf16*)outp, l, vcu, G, tid, z_);
        } else if constexpr (sp == 5) {
            if constexpr ((PHM & 64) != 0) { dattn_setup(a, lds, l, tid, lane);
                for (int u = vcu; u < NB * 64; u += G) dattn_unit(a, ws, lds, l, u, tid, wid, lane, dry); }
            if constexpr ((PHM & 128) != 0) { for (int u = vcu; u < NB * 64; u += G) r2_unit(a, ws, (bf16*)outp, lds, l, u, tid, wid, lane, dry); }
        } else if constexpr ((PHM & 256) != 0 && sp == 9 && l == 1) {
            phase_fnorm(a, ws, outp, l, vcu, G, wid, lane);
        }
    }
}
template <int PHM> __global__ void __launch_bounds__(512) fwd_kernel(Args a0) {
    extern __shared__ __attribute__((aligned(16))) unsigned char lds_raw[];
    LAS unsigned char* lds0 = (LAS unsigned char*)lds_raw;
    cg::grid_group grid = cg::this_grid();
    const int lo = a0.lo, hi = a0.hi;
    if (threadIdx.x < 2) ((LAS unsigned*)(lds0 + LDS_BARW))[threadIdx.x] = 0u;
    __syncthreads();
    XcdBarrier xbar; xbar.bar = (unsigned*)(a0.ws + WS_BAR); xbar.x = 0; xbar.st = (volatile LAS unsigned*)(lds0 + LDS_BARW);
    if (hi - lo > 1) xbar = xcd_barrier_post((unsigned*)(a0.ws + WS_BAR), (volatile LAS unsigned*)(lds0 + LDS_BARW));
#define RUN(k) if ((k) != 10 && lo <= (k) && (k) < hi) { run_phase<PHM, (k)>(a0, lds0, a0.dry); if ((k) + 1 < hi) { if ((k) == 0) grid.sync(); else xcd_barrier(xbar); } }
    RUN(0) RUN(1) RUN(2) RUN(3) RUN(4) RUN(5) RUN(6) RUN(7) RUN(8) RUN(9) RUN(10)
    RUN(11) RUN(12) RUN(13) RUN(14) RUN(15) RUN(16) RUN(17) RUN(18) RUN(19) RUN(20)
#undef RUN
}

#ifndef N_LAUNCH_MODE
#define N_LAUNCH_MODE 1
#endif
template <int PHM> static void launch_one(const Args& a, int grid, hipStream_t stream) { hipLaunchKernelGGL(fwd_kernel<PHM>, dim3(grid), dim3(512), LDS_BYTES, stream, a); }
template <int PHM> static void set_lds() { (void)hipFuncSetAttribute((const void*)fwd_kernel<PHM>, hipFuncAttributeMaxDynamicSharedMemorySize, LDS_BYTES); }
extern "C" void kernel_launch(void* const* d_in, const int* in_sizes, int n_in, void* d_out, int out_size, void* d_ws, size_t ws_size, hipStream_t stream) {
    static int grid = 0;
    if (grid == 0) {
        if (n_in != 21 || ws_size < WS_END) { fprintf(stderr, "kernel_launch: unexpected inputs (n_in %d, ws %zu)\n", n_in, ws_size); grid = -1; return; }
        int dev = 0, cus = 0, per_cu = 0;
        (void)hipGetDevice(&dev); (void)hipDeviceGetAttribute(&cus, hipDeviceAttributeMultiprocessorCount, dev);
#if N_LAUNCH_MODE == 1
        set_lds<511>();
        (void)hipOccupancyMaxActiveBlocksPerMultiprocessor(&per_cu, (const void*)fwd_kernel<511>, 512, LDS_BYTES);
#else
        set_lds<1>(); set_lds<2>(); set_lds<4>(); set_lds<8>(); set_lds<16>(); set_lds<32>(); set_lds<64>(); set_lds<128>(); set_lds<256>();
        per_cu = 1;
#endif
        if (per_cu < 1) { fprintf(stderr, "kernel_launch: occupancy query returned %d\n", per_cu); per_cu = 1; }
        (void)hipGetLastError();
        grid = cus * per_cu;
    }
    if (grid < 0) return;
    Args a{};
    for (int i = 0; i < 21; ++i) a.in[i] = (const float*)d_in[i];
    a.out = (float*)d_out; a.ws = (unsigned char*)d_ws;
#if N_LAUNCH_MODE == 1
    (void)hipMemsetAsync((unsigned char*)d_ws + WS_BAR, 0, WS_BAR_BYTES, stream);
    a.lo = 0; a.hi = NPHASE;
    void* args[] = {&a};
    hipError_t e = hipLaunchCooperativeKernel((const void*)fwd_kernel<511>, dim3(grid), dim3(512), args, LDS_BYTES, stream);
    if (e != hipSuccess) fprintf(stderr, "cooperative launch failed: %s (grid %d)\n", hipGetErrorString(e), grid);
#else
    for (int ph = 0; ph < NPHASE; ++ph) {
        a.lo = ph; a.hi = ph + 1;
        const int sp = ph == 0 ? 11 : (ph - 1) % 10;
        const int nrep = 1 + ((PROBE_DUP >> sp) & 1), nrepB = 1 + ((PROBE_DUP >> 10) & 1);
        for (int rep = 0; rep < nrep; ++rep) {
            a.dry = (rep + 1 < nrep) ? 1 : 0;
            if (ph == 0) launch_one<1>(a, grid, stream);
            else if (sp == 0 || sp == 7) launch_one<2>(a, grid, stream);
            else if (sp == 1 || sp == 8 || sp == 6) launch_one<4>(a, grid, stream);
            else if (sp == 2) launch_one<8>(a, grid, stream);
            else if (sp == 3) launch_one<16>(a, grid, stream);
            else if (sp == 4) launch_one<32>(a, grid, stream);
            else if (sp == 5) { launch_one<64>(a, grid, stream); if (rep == 0) for (int rb = 0; rb < nrepB; ++rb) { Args b = a; b.dry = (rb + 1 < nrepB) ? 1 : 0; launch_one<128>(b, grid, stream); } }
            else launch_one<256>(a, grid, stream);
        }
    }
#endif
}
```

```cpp
#include <hip/hip_runtime.h>
#include <hip/hip_cooperative_groups.h>
#include <cstdio>
#include <cstdint>
namespace cg = cooperative_groups;
namespace pg8 {
#define PG8_LAS __attribute__((address_space(3)))
typedef unsigned short bf16_t;
typedef short bf16x8 __attribute__((ext_vector_type(8)));
typedef float f32x4 __attribute__((ext_vector_type(4)));
typedef unsigned u32x4 __attribute__((ext_vector_type(4)));
constexpr int BM = 256, BK = 64, HALF = 128, HTB = HALF * BK * 2  , STAGE_BYTES = 8 * HTB, NXCD = 8, WGM = 8;

__host__ __device__ __forceinline__ int lds_byte(int r, int c) { const int st = (r >> 4) * 2 + (c >> 5), rr = r & 15, cc = c & 31, ob = rr * 64 + cc * 2; return st * 1024 + (ob ^ (((ob >> 9) & 1) << 5)); }
__host__ __device__ __forceinline__ void stage_rc(int b, int& R, int& C) { const int st = b / 1024, sb = b % 1024, swz = sb ^ (((sb >> 9) & 1) << 5); R = (st >> 1) * 16 + swz / 64; C = (st & 1) * 32 + (swz % 64) / 2; }
__host__ __device__ __forceinline__ int perm32(int rho) { const int n = rho >> 4, i = rho & 15; return 8 * (i >> 2) + 4 * n + (i & 3); }

struct Unit { int pm, pn; };
struct Gemm { const bf16_t* A; const bf16_t* Bt; int M, N, K, lda; };

struct StaticOrder {
    int nM, nN, nwg, G, c;
    __host__ __device__ void init(int M, int N, int G_, int c_) { nM = M / BM; nN = N / BM; nwg = nM * nN; G = G_; c = c_; }
    __host__ __device__ bool next(int i, Unit& u) const {
        const long L = (long)i * G + c; if (L >= nwg) return false;
        int wgid = (int)L; { const int q = nwg / NXCD, r = nwg % NXCD, xcd = wgid % NXCD, off = wgid / NXCD; wgid = (xcd < r ? xcd * (q + 1) : r * (q + 1) + (xcd - r) * q) + off; }
        const int nig = WGM * nN, gid = wgid / nig, fm = gid * WGM, gsz = (nM - fm) < WGM ? (nM - fm) : WGM;
        u.pm = fm + ((wgid % nig) % gsz); u.pn = (wgid % nig) / gsz; return true;
    }
    __device__ __forceinline__ void a_ready(const Unit&) const {}
    __device__ __forceinline__ void done(const Unit&) const {}
};

__device__ __forceinline__ unsigned cvt_pk_bf16(float lo, float hi) { unsigned r; asm volatile("v_cvt_pk_bf16_f32 %0, %1, %2" : "=v"(r) : "v"(lo), "v"(hi)); return r; }
typedef float f32x2 __attribute__((ext_vector_type(2)));
template <class Epi, class Sched, bool ALIGN_EPI = false, bool SP2 = false>
__device__ __forceinline__ void gemm_phase(PG8_LAS unsigned char* lds, const Gemm g, const Sched& S, const Epi& E, const int tid) {
    const int wid = __builtin_amdgcn_readfirstlane(tid >> 6), lane = tid & 63, wr = wid >> 2, wc = wid & 3, fr = lane & 15, fq = lane >> 4;
    const int K = g.K, nt = K / BK;
    unsigned voffA[2], voffB[2];
#pragma unroll
    for (int i = 0; i < 2; ++i) { int R, C; stage_rc(tid * 16 + i * 8192, R, C); const int Rb = Epi::PERM ? ((R & ~31) + perm32(R & 31)) : R;
        voffA[i] = (unsigned)(R * g.lda + C) * 2u; voffB[i] = (unsigned)(Rb * K + C) * 2u; }
    const size_t kstep = (size_t)(BK * 2);
    const size_t hstep = (size_t)HALF * K * 2;
    const size_t tstep = 2 * hstep; const size_t hstepA = (size_t)HALF * g.lda * 2, tstepA = 2 * hstepA;
    const unsigned ldsw = (unsigned)wid * 1024u;
    const int aoff = lds_byte(wr * 64 + fr, fq * 8), boff = lds_byte(wc * 32 + fr, fq * 8);
#define PG8_SA(b, h) (((b) * 2 + (h)) * HTB)
#define PG8_SB(b, h) ((4 + (b) * 2 + (h)) * HTB)
#define PG8_STAGE(bufoff, gbase, voff) do { _Pragma("unroll") for (int _i = 0; _i < 2; ++_i) \
        __builtin_amdgcn_global_load_lds((const unsigned*)((const char*)(gbase) + (voff)[_i]), (PG8_LAS unsigned*)(lds + (bufoff) + ldsw + _i * 8192), 16, 0, 0); } while (0)
#define PG8_LDA(dst, b, h) do { _Pragma("unroll") for (int m = 0; m < 4; ++m) _Pragma("unroll") for (int k = 0; k < 2; ++k) dst[m][k] = *(const PG8_LAS bf16x8*)(lds + PG8_SA(b, h) + aoff + m * 2048 + k * 1024); } while (0)
#define PG8_LDB(dst, b, h) do { _Pragma("unroll") for (int n = 0; n < 2; ++n) _Pragma("unroll") for (int k = 0; k < 2; ++k) dst[n][k] = *(const PG8_LAS bf16x8*)(lds + PG8_SB(b, h) + boff + n * 2048 + k * 1024); } while (0)
#define PG8_MMA(ai, bj, At, Bt) do { __builtin_amdgcn_s_setprio(1); _Pragma("unroll") for (int m = 0; m < 4; ++m) _Pragma("unroll") for (int n = 0; n < 2; ++n) _Pragma("unroll") for (int k = 0; k < 2; ++k) \
        acc[ai][bj][m][n] = __builtin_amdgcn_mfma_f32_16x16x32_bf16(Bt[n][k], At[m][k], acc[ai][bj][m][n], 0, 0, 0); __builtin_amdgcn_s_setprio(0); } while (0)
#define PG8_WAIT_V(n) asm volatile("s_waitcnt vmcnt(" #n ")" ::: "memory")
#define PG8_WAIT_L(n) asm volatile("s_waitcnt lgkmcnt(" #n ")" ::: "memory")
#define PG8_BAR __builtin_amdgcn_s_barrier()
#define PG8_SCHED __builtin_amdgcn_sched_barrier(0)
    Unit cur, nxt; int ui = 0;
    if (!S.next(0, cur)) return;
    f32x4 acc[2][2][4][2];
#pragma unroll
    for (int a = 0; a < 2; ++a)
#pragma unroll
        for (int b = 0; b < 2; ++b)
#pragma unroll
            for (int m = 0; m < 4; ++m)
#pragma unroll
                for (int n = 0; n < 2; ++n) acc[a][b][m][n] = (f32x4){0.f, 0.f, 0.f, 0.f};
    bf16x8 At[4][2], B0[2][2], B1[2][2];
    const char* cA = (const char*)g.A + (size_t)cur.pm * tstepA; const char* cB = (const char*)g.Bt + (size_t)cur.pn * tstep;
    S.a_ready(cur);
    if constexpr (SP2) {
        PG8_STAGE(PG8_SB(0, 0), cB, voffB); PG8_STAGE(PG8_SB(0, 1), cB + hstep, voffB); PG8_STAGE(PG8_SA(0, 0), cA, voffA); PG8_STAGE(PG8_SA(0, 1), cA + hstepA, voffA);
        if (wr == 1) PG8_BAR;
        PG8_WAIT_V(2); PG8_BAR;
        PG8_STAGE(PG8_SB(1, 0), cB + kstep, voffB); PG8_STAGE(PG8_SA(1, 0), cA + kstep, voffA); PG8_STAGE(PG8_SB(1, 1), cB + hstep + kstep, voffB);
        PG8_WAIT_V(6); PG8_BAR;
    } else {
        PG8_STAGE(PG8_SB(0, 0), cB, voffB); PG8_STAGE(PG8_SA(0, 0), cA, voffA); PG8_STAGE(PG8_SB(0, 1), cB + hstep, voffB); PG8_STAGE(PG8_SA(0, 1), cA + hstepA, voffA);
        if (wr == 1) PG8_BAR;
        PG8_WAIT_V(4); PG8_BAR;
        PG8_STAGE(PG8_SB(1, 0), cB + kstep, voffB); PG8_STAGE(PG8_SA(1, 0), cA + kstep, voffA); PG8_STAGE(PG8_SB(1, 1), cB + hstep + kstep, voffB);
        PG8_WAIT_V(6); PG8_BAR;
    }
    for (;;) {
        const bool has_next = S.next(ui + 1, nxt);
        const char* nA = has_next ? (const char*)g.A + (size_t)nxt.pm * tstepA : cA; const char* nB = has_next ? (const char*)g.Bt + (size_t)nxt.pn * tstep : cB;
        for (int t = 0; t < nt; t += 2) {
            const bool last = (t == nt - 2);
            const char* a1 = cA + (size_t)(t + 1) * kstep;
            const char* a2 = last ? nA : cA + (size_t)(t + 2) * kstep; const char* b2 = last ? nB : cB + (size_t)(t + 2) * kstep;
            const char* a3 = a2 + kstep; const char* b3 = b2 + kstep;
            if (last && has_next) S.a_ready(nxt);
            if constexpr (SP2) {
            PG8_LDB(B0, 0, 0); PG8_LDB(B1, 0, 1); PG8_SCHED; PG8_LDA(At, 0, 0); PG8_STAGE(PG8_SA(1, 1), a1 + hstepA, voffA);
            PG8_WAIT_V(8); PG8_WAIT_L(0); PG8_BAR; PG8_MMA(0, 0, At, B0); PG8_MMA(0, 1, At, B1); PG8_BAR; PG8_SCHED;
            PG8_LDA(At, 0, 1); PG8_STAGE(PG8_SB(0, 0), b2, voffB); PG8_STAGE(PG8_SB(0, 1), b2 + hstep, voffB); PG8_STAGE(PG8_SA(0, 0), a2, voffA);
            PG8_WAIT_V(8); PG8_WAIT_L(0); PG8_BAR; PG8_MMA(1, 0, At, B0); PG8_MMA(1, 1, At, B1); PG8_BAR; PG8_SCHED;
            PG8_LDB(B0, 1, 0); PG8_LDB(B1, 1, 1); PG8_SCHED; PG8_LDA(At, 1, 0); PG8_STAGE(PG8_SA(0, 1), a2 + hstepA, voffA);
            PG8_WAIT_V(8); PG8_WAIT_L(0); PG8_BAR; PG8_MMA(0, 0, At, B0); PG8_MMA(0, 1, At, B1); PG8_BAR; PG8_SCHED;
            PG8_LDA(At, 1, 1); PG8_STAGE(PG8_SB(1, 0), b3, voffB); PG8_STAGE(PG8_SB(1, 1), b3 + hstep, voffB); PG8_STAGE(PG8_SA(1, 0), a3, voffA);
            PG8_WAIT_V(8); PG8_WAIT_L(0); PG8_BAR; PG8_MMA(1, 0, At, B0); PG8_MMA(1, 1, At, B1); PG8_BAR; PG8_SCHED;
            } else {
            PG8_LDB(B0, 0, 0); PG8_SCHED; PG8_LDA(At, 0, 0); PG8_STAGE(PG8_SA(1, 1), a1 + hstepA, voffA);
            PG8_WAIT_L(8); PG8_BAR; PG8_WAIT_L(0); PG8_MMA(0, 0, At, B0); PG8_BAR; PG8_SCHED;
            PG8_LDB(B1, 0, 1); PG8_STAGE(PG8_SB(0, 0), b2, voffB);
            PG8_BAR; PG8_WAIT_L(0); PG8_MMA(0, 1, At, B1); PG8_BAR;
            PG8_LDA(At, 0, 1); PG8_STAGE(PG8_SA(0, 0), a2, voffA);
            PG8_BAR; PG8_WAIT_L(0); PG8_MMA(1, 0, At, B0); PG8_BAR; PG8_SCHED;
            PG8_STAGE(PG8_SB(0, 1), b2 + hstep, voffB);
            PG8_WAIT_V(6); PG8_BAR; PG8_MMA(1, 1, At, B1); PG8_BAR;
            PG8_LDB(B0, 1, 0); PG8_SCHED; PG8_LDA(At, 1, 0); PG8_STAGE(PG8_SA(0, 1), a2 + hstepA, voffA);
            PG8_WAIT_L(8); PG8_BAR; PG8_WAIT_L(0); PG8_MMA(0, 0, At, B0); PG8_BAR; PG8_SCHED;
            PG8_LDB(B1, 1, 1); PG8_STAGE(PG8_SB(1, 0), b3, voffB);
            PG8_BAR; PG8_WAIT_L(0); PG8_MMA(0, 1, At, B1); PG8_BAR;
            PG8_LDA(At, 1, 1); PG8_STAGE(PG8_SA(1, 0), a3, voffA);
            PG8_BAR; PG8_WAIT_L(0); PG8_MMA(1, 0, At, B0); PG8_BAR; PG8_SCHED;
            PG8_STAGE(PG8_SB(1, 1), b3 + hstep, voffB);
            PG8_WAIT_V(6); PG8_BAR; PG8_MMA(1, 1, At, B1); PG8_BAR;
            }
        }
        if constexpr (ALIGN_EPI) { if (wr == 0) PG8_BAR; }
        if constexpr (!Epi::AFTER_DRAIN) { E(acc, cur, wr, wc, fr, fq); S.done(cur); }
        if (!has_next) break;
#pragma unroll
        for (int a = 0; a < 2; ++a)
#pragma unroll
            for (int b = 0; b < 2; ++b)
#pragma unroll
                for (int m = 0; m < 4; ++m)
#pragma unroll
                    for (int n = 0; n < 2; ++n) acc[a][b][m][n] = (f32x4){0.f, 0.f, 0.f, 0.f};
        cur = nxt; cA = nA; cB = nB; ++ui;
        if constexpr (ALIGN_EPI) { if (wr == 1) PG8_BAR; }
    }
    PG8_WAIT_V(0);
    if constexpr (!ALIGN_EPI) { if (wr == 0) PG8_BAR; }
    PG8_BAR;
    if constexpr (Epi::AFTER_DRAIN) { E.fused(acc, cur, wr, wc, fr, fq, lds, wid, lane); S.done(cur); }
#undef PG8_SA
#undef PG8_SB
#undef PG8_STAGE
#undef PG8_LDA
#undef PG8_LDB
#undef PG8_MMA
#undef PG8_WAIT_V
#undef PG8_WAIT_L
#undef PG8_BAR
#undef PG8_SCHED
}
}

#define LAS __attribute__((address_space(3)))
typedef unsigned short bf16;
typedef short bf16x8 __attribute__((ext_vector_type(8)));
typedef short v4i16_t __attribute__((ext_vector_type(4)));
typedef float f32x4 __attribute__((ext_vector_type(4)));
typedef float f32x2 __attribute__((ext_vector_type(2)));
typedef float f32x16 __attribute__((ext_vector_type(16)));
typedef unsigned u32x4 __attribute__((ext_vector_type(4)));
typedef unsigned u32x2 __attribute__((ext_vector_type(2)));

constexpr int T = 98304, TP = 32768, DM = 1024, FF = 2816, NIN = 3584, SEQ = 2048, NB = 48;
constexpr float EPS = 1e-6f, LOG2E = 1.4426950408889634f;
constexpr float C2 = 0.125f * LOG2E;
constexpr size_t MiB = 1u << 20;
constexpr size_t WS_STAT = 8 * MiB  , WS_ROT = 4 * MiB, WS_W = 16 * MiB, W_LAYER = 42 * MiB, WS_HB = 104 * MiB, WS_P = 296 * MiB, WS_END = 968 * MiB;
constexpr size_t WO_GU1 = 0, WO_D1 = 11534336, WO_IN = WO_D1 + 5767168, WO_OUT = WO_IN + 7340032, WO_GU2 = WO_OUT + 2097152, WO_D2 = WO_GU2 + 11534336;
static_assert(WO_D2 + 5767168 == W_LAYER, "weight map");
constexpr int LDS_BYTES = 147456;
constexpr int LDS_TAB = 131072, LDS_MISC = 139264, LDS_STATS = 131072, LDS_BARW = 143360;
constexpr size_t WS_BAR = 5 * MiB, WS_BAR_BYTES = 16384;
constexpr int NPHASE = 21;

typedef unsigned long long u64;
__device__ __forceinline__ float ss_scale(const u64* ss, int row) { return __builtin_amdgcn_rsqf((float)ss[row] * (1.f / 4294967296.f / 1024.f) + EPS); }
__device__ __forceinline__ u64 ss_fix(float q) { return (u64)(q * 4294967296.f); }
struct Args { const float* in[21]; float* out; unsigned char* ws; int lo, hi, dry, pad; };

#define LDS_WAIT() asm volatile("s_waitcnt lgkmcnt(0)" ::: "memory")

__device__ __forceinline__ unsigned pkbf(float lo, float hi) { typedef __bf16 bf2_t __attribute__((ext_vector_type(2))); f32x2 v = {lo, hi}; bf2_t b = __builtin_convertvector(v, bf2_t); return __builtin_bit_cast(unsigned, b); }
__device__ __forceinline__ float bflo(unsigned u) { return __builtin_bit_cast(float, u << 16); }
__device__ __forceinline__ float bfhi(unsigned u) { return __builtin_bit_cast(float, u & 0xffff0000u); }
__device__ __forceinline__ float wave_sum(float v) {
#pragma unroll
    for (int o = 1; o < 64; o <<= 1) v += __shfl_xor(v, o);
    return v;
}
__device__ __forceinline__ float wave_max(float v) {
#pragma unroll
    for (int o = 1; o < 64; o <<= 1) v = fmaxf(v, __shfl_xor(v, o));
    return v;
}
__device__ __forceinline__ float silu_f(float g) { return g * __builtin_amdgcn_rcpf(1.f + __builtin_amdgcn_exp2f(-g * LOG2E)); }
__device__ __forceinline__ int crow(int r, int hi) { return (r & 3) + 8 * (r >> 2) + 4 * hi; }
__device__ __forceinline__ unsigned offb(unsigned row, unsigned ch) { return 256u * row + 16u * (ch ^ (((row & 3u) << 2) | ((row >> 2) & 3u))); }
__device__ __forceinline__ unsigned tr_base_perm(int c, int tt, int lane) {
    const unsigned hi = lane >> 5, g1 = (lane >> 4) & 1, q4 = (lane & 15) >> 2, p4 = lane & 3, lowc = 2 * g1 + (p4 >> 1);
    return 1024u * hi + 256u * q4 + 8u * (p4 & 1) + 64u * ((unsigned)c ^ q4) + 16u * ((lowc ^ hi) ^ (2u * tt));
}
__device__ __forceinline__ unsigned tr_base_nat(int c, int tt, int lane) {
    const unsigned hi = lane >> 5, g1 = (lane >> 4) & 1, q4 = (lane & 15) >> 2, p4 = lane & 3, lowc = 2 * g1 + (p4 >> 1);
    return 2048u * hi + 256u * q4 + 8u * (p4 & 1) + 64u * ((unsigned)c ^ q4) + 16u * ((lowc ^ (2u * hi)) ^ (unsigned)tt);
}
__device__ __forceinline__ unsigned row_base(int cK, int lane) {
    const unsigned r32 = lane & 31, hi = lane >> 5, xk = ((r32 & 3u) << 2) | ((r32 >> 2) & 3u);
    return 256u * r32 + 16u * (((unsigned)cK + hi) ^ xk);
}
__device__ __forceinline__ bf16x8 tr_pair(const LAS unsigned char* p0, const LAS unsigned char* p1) {
    const v4i16_t lo = __builtin_amdgcn_ds_read_tr16_b64_v4i16((LAS v4i16_t*)p0);
    const v4i16_t hi = __builtin_amdgcn_ds_read_tr16_b64_v4i16((LAS v4i16_t*)p1);
    return (bf16x8){lo[0], lo[1], lo[2], lo[3], hi[0], hi[1], hi[2], hi[3]};
}
__device__ __forceinline__ bf16x8 pack8(const f32x16& S, int s) {
    u32x4 w; w.x = pkbf(S[8 * s + 0], S[8 * s + 1]); w.y = pkbf(S[8 * s + 2], S[8 * s + 3]); w.z = pkbf(S[8 * s + 4], S[8 * s + 5]); w.w = pkbf(S[8 * s + 6], S[8 * s + 7]);
    return __builtin_bit_cast(bf16x8, w);
}
__device__ __forceinline__ int rel_bucket(int rel) {
    const int n = rel < 0 ? -rel : rel; int b;
    if (n < 8) b = n; else if (n < 12) b = 8; else if (n < 16) b = 9; else if (n < 23) b = 10; else if (n < 32) b = 11; else if (n < 46) b = 12; else if (n < 64) b = 13; else if (n < 91) b = 14; else b = 15;
    return b + (rel > 0 ? 16 : 0);
}

template <bool NN> struct EpiSwiGLU {
    static constexpr bool PERM = true, AFTER_DRAIN = false;
    bf16* O; const u64* ss; const u64* ssw;
    __device__ __forceinline__ void operator()(const f32x4 (&acc)[2][2][4][2], const pg8::Unit& u, int wr, int wc, int fr, int fq) const {
        const int row0 = u.pm * 256 + wr * 64 + fr, col0 = u.pn * 128 + wc * 32 + 8 * fq;
#pragma unroll
        for (int ai = 0; ai < 2; ++ai)
#pragma unroll
            for (int m = 0; m < 4; ++m) {
                const int row = row0 + ai * 128 + m * 16;
                float s = ss_scale(ss, row);
                if constexpr (NN) s *= __builtin_amdgcn_rsqf(s * s * (float)ssw[row] * (1.f / 4294967296.f / 1024.f) + EPS);
                float a[8];
#pragma unroll
                for (int n = 0; n < 2; ++n)
#pragma unroll
                    for (int i = 0; i < 4; ++i) { const float g = acc[ai][0][m][n][i] * s, uu = acc[ai][1][m][n][i] * s; a[4 * n + i] = silu_f(g) * uu; }
                u32x4 w; w.x = pkbf(a[0], a[1]); w.y = pkbf(a[2], a[3]); w.z = pkbf(a[4], a[5]); w.w = pkbf(a[6], a[7]);
                *(u32x4*)(O + (size_t)row * FF + col0) = w;
            }
    }
};
template <int MODE, bool WF32> struct EpiRes {
    static constexpr bool PERM = true, AFTER_DRAIN = false;
    float* out; bf16* hb; u64* ssn; int dry; const float* gf; const u64* rss; u64* ssw;
    __device__ __forceinline__ void operator()(const f32x4 (&acc)[2][2][4][2], const pg8::Unit& u, int wr, int wc, int fr, int fq) const {
        if (dry) return;
        const int row0 = u.pm * 256 + wr * 64 + fr, col0 = u.pn * 256 + wc * 32 + 8 * fq;
        f32x4 g0[2], g1[2];
        if constexpr (MODE != 0) {
#pragma unroll
            for (int bj = 0; bj < 2; ++bj) { g0[bj] = *(const f32x4*)(gf + col0 + bj * 128); g1[bj] = *(const f32x4*)(gf + col0 + bj * 128 + 4); if constexpr (MODE == 1) { g0[bj] = g0[bj] * g0[bj]; g1[bj] = g1[bj] * g1[bj]; } }
        }
#pragma unroll
        for (int ai = 0; ai < 2; ++ai)
#pragma unroll
            for (int m = 0; m < 4; ++m) {
                const int row = row0 + ai * 128 + m * 16;
                float q = 0.f, qw = 0.f, sh = 1.f;
                if constexpr (MODE == 2) sh = ss_scale(rss, row);
#pragma unroll
                for (int bj = 0; bj < 2; ++bj) {
                    const int c = col0 + bj * 128;
                    const u32x4 rb = *(const u32x4*)(hb + (size_t)row * DM + c);
                    f32x4 r0 = {bflo(rb.x), bfhi(rb.x), bflo(rb.y), bfhi(rb.y)}, r1 = {bflo(rb.z), bfhi(rb.z), bflo(rb.w), bfhi(rb.w)};
                    if constexpr (MODE == 2) { r0 = r0 * sh * g0[bj]; r1 = r1 * sh * g1[bj]; }
                    const f32x4 v0 = r0 + acc[ai][bj][m][0], v1 = r1 + acc[ai][bj][m][1];
                    if constexpr (WF32) { *(f32x4*)(out + (size_t)row * DM + c) = v0; *(f32x4*)(out + (size_t)row * DM + c + 4) = v1; }
                    u32x4 w; w.x = pkbf(v0[0], v0[1]); w.y = pkbf(v0[2], v0[3]); w.z = pkbf(v1[0], v1[1]); w.w = pkbf(v1[2], v1[3]);
                    *(u32x4*)(hb + (size_t)row * DM + c) = w;
                    const f32x4 s0 = v0 * v0, s1 = v1 * v1;
                    q += (s0[0] + s0[1]) + (s0[2] + s0[3]) + (s1[0] + s1[1]) + (s1[2] + s1[3]);
                    if constexpr (MODE == 1) { const f32x4 t0 = s0 * g0[bj], t1 = s1 * g1[bj]; qw += (t0[0] + t0[1]) + (t0[2] + t0[3]) + (t1[0] + t1[1]) + (t1[2] + t1[3]); }
                }
                q += __shfl_xor(q, 16); q += __shfl_xor(q, 32);
                if constexpr (MODE == 1) { qw += __shfl_xor(qw, 16); qw += __shfl_xor(qw, 32); }
                if (fq == 0) {
                    __hip_atomic_fetch_add(ssn + row, ss_fix(q), __ATOMIC_RELAXED, __HIP_MEMORY_SCOPE_AGENT);
                    if constexpr (MODE == 1) __hip_atomic_fetch_add(ssw + row, ss_fix(qw), __ATOMIC_RELAXED, __HIP_MEMORY_SCOPE_AGENT);
                }
            }
    }
};
struct EpiWin {
    static constexpr bool PERM = true, AFTER_DRAIN = false;
    bf16* P; const u64* ss; const f32x2* rot; const float* qg; const float* kg;
    __device__ __forceinline__ void operator()(const f32x4 (&acc)[2][2][4][2], const pg8::Unit& u, int wr, int wc, int fr, int fq) const {
        const int type = u.pn >> 1;
        const int row0 = u.pm * 256 + wr * 64 + fr, cbase = u.pn * 256;
        if (type <= 1) {
            const int hh = wc >> 1, j0 = 32 * (wc & 1) + 8 * fq;
#pragma unroll
            for (int ai = 0; ai < 2; ++ai)
#pragma unroll
                for (int m = 0; m < 4; ++m) {
                    const int row = row0 + ai * 128 + m * 16;
                    const float s = ss_scale(ss, row);
                    const f32x4* rp = (const f32x4*)(rot + (size_t)(row & (SEQ - 1)) * 64 + j0);
                    float o1[8], o2[8];
#pragma unroll
                    for (int n = 0; n < 2; ++n) {
                        const f32x4 cs0 = rp[2 * n], cs1 = rp[2 * n + 1];
                        const float cc[4] = {cs0[0], cs0[2], cs1[0], cs1[2]}, sn[4] = {cs0[1], cs0[3], cs1[1], cs1[3]};
#pragma unroll
                        for (int i = 0; i < 4; ++i) { const float x1 = acc[ai][0][m][n][i] * s, x2 = acc[ai][1][m][n][i] * s; o1[4 * n + i] = x1 * cc[i] - x2 * sn[i]; o2[4 * n + i] = x1 * sn[i] + x2 * cc[i]; }
                    }
                    bf16* op = P + (size_t)row * NIN + cbase + hh * 128 + j0;
                    u32x4 w; w.x = pkbf(o1[0], o1[1]); w.y = pkbf(o1[2], o1[3]); w.z = pkbf(o1[4], o1[5]); w.w = pkbf(o1[6], o1[7]); *(u32x4*)op = w;
                    w.x = pkbf(o2[0], o2[1]); w.y = pkbf(o2[2], o2[3]); w.z = pkbf(o2[4], o2[5]); w.w = pkbf(o2[6], o2[7]); *(u32x4*)(op + 64) = w;
                }
        } else if (type == 4 || type == 5) {
            const int hh = wc >> 1, t = wc & 1; const float* gp = (type == 4 ? qg : kg) + t * 64 + 8 * fq; const float mul = (type == 4) ? C2 : 1.f;
            float gv[2][8];
#pragma unroll
            for (int bj = 0; bj < 2; ++bj)
#pragma unroll
                for (int i = 0; i < 8; ++i) gv[bj][i] = gp[bj * 32 + i] * mul;
#pragma unroll
            for (int ai = 0; ai < 2; ++ai)
#pragma unroll
                for (int m = 0; m < 4; ++m) {
                    const int row = row0 + ai * 128 + m * 16;
                    const float s = ss_scale(ss, row);
                    float v[2][8]; float q = 0.f;
#pragma unroll
                    for (int bj = 0; bj < 2; ++bj)
#pragma unroll
                        for (int n = 0; n < 2; ++n)
#pragma unroll
                            for (int i = 0; i < 4; ++i) { const float x = acc[ai][bj][m][n][i] * s; v[bj][4 * n + i] = x; q += x * x; }
                    q += __shfl_xor(q, 16); q += __shfl_xor(q, 32);
                    const float rs = __builtin_amdgcn_rsqf(q * (1.f / 64.f) + EPS);
                    bf16* op = P + (size_t)row * NIN + cbase + hh * 128 + t * 64 + 8 * fq;
#pragma unroll
                    for (int bj = 0; bj < 2; ++bj) {
                        u32x4 w; w.x = pkbf(v[bj][0] * rs * gv[bj][0], v[bj][1] * rs * gv[bj][1]); w.y = pkbf(v[bj][2] * rs * gv[bj][2], v[bj][3] * rs * gv[bj][3]);
                        w.z = pkbf(v[bj][4] * rs * gv[bj][4], v[bj][5] * rs * gv[bj][5]); w.w = pkbf(v[bj][6] * rs * gv[bj][6], v[bj][7] * rs * gv[bj][7]);
                        *(u32x4*)(op + bj * 32) = w;
                    }
                }
        } else {
            const bool act = (type == 3);
#pragma unroll
            for (int ai = 0; ai < 2; ++ai)
#pragma unroll
                for (int m = 0; m < 4; ++m) {
                    const int row = row0 + ai * 128 + m * 16;
                    const float s = ss_scale(ss, row);
                    bf16* op = P + (size_t)row * NIN + cbase + wc * 32 + 8 * fq;
#pragma unroll
                    for (int bj = 0; bj < 2; ++bj) {
                        float v[8];
#pragma unroll
                        for (int n = 0; n < 2; ++n)
#pragma unroll
                            for (int i = 0; i < 4; ++i) { const float x = acc[ai][bj][m][n][i] * s; v[4 * n + i] = act ? silu_f(x) : x; }
                        u32x4 w; w.x = pkbf(v[0], v[1]); w.y = pkbf(v[2], v[3]); w.z = pkbf(v[4], v[5]); w.w = pkbf(v[6], v[7]);
                        *(u32x4*)(op + bj * 128) = w;
                    }
                }
        }
    }
};

__device__ __forceinline__ void tr_item(const float* W, int ldw, int K, int k0, int srccol0, bf16* WT, int dstrow0, const float* gain, float scale, LAS float* scr, int lane, const float* gain2 = nullptr) {
#pragma unroll
    for (int i = 0; i < 32; ++i) { const int kk = 2 * i + (lane >> 5); float gsc = gain ? gain[k0 + kk] * scale : scale; if (gain2) gsc *= gain2[k0 + kk]; scr[kk * 33 + (lane & 31)] = W[(size_t)(k0 + kk) * ldw + srccol0 + (lane & 31)] * gsc; }
    LDS_WAIT();
    const int c = lane & 7;
#pragma unroll
    for (int j = 0; j < 4; ++j) { const int n = (lane >> 3) + 8 * j; const LAS float* s = scr + (8 * c) * 33 + n;
        u32x4 o; o.x = pkbf(s[0 * 33], s[1 * 33]); o.y = pkbf(s[2 * 33], s[3 * 33]); o.z = pkbf(s[4 * 33], s[5 * 33]); o.w = pkbf(s[6 * 33], s[7 * 33]);
        *(u32x4*)(WT + (size_t)(dstrow0 + n) * K + k0 + 8 * c) = o; }
    LDS_WAIT();
}
__device__ __forceinline__ void phase_prep(const Args& a, unsigned char* ws, LAS unsigned char* lds, int vcu, int G, int tid, int wid, int lane) {
    LAS float* scr = (LAS float*)(lds + wid * 16384);
    const int gw = vcu * 8 + wid, NGW = G * 8;
    constexpr int I_GU = 16 * 176, I_D = 44 * 32, I_IN = 16 * 112, I_OUT = 16 * 32, I_L = 2 * I_GU + 2 * I_D + I_IN + I_OUT;
    for (int it = gw; it < 2 * I_L; it += NGW) {
        const int l = it / I_L; int r = it % I_L;
        unsigned char* wl = ws + WS_W + (size_t)l * W_LAYER;
        if (r < I_GU || (r >= I_GU + I_D + I_IN + I_OUT && r < 2 * I_GU + I_D + I_IN + I_OUT)) {
            const bool second = r >= I_GU; if (second) r -= I_GU + I_D + I_IN + I_OUT;
            const int kb = r / 176, nb = r % 176, n0 = nb * 32, pn = n0 >> 8, half = (n0 >> 7) & 1, j0 = n0 & 127;
            const float* src = a.in[second ? (half ? 18 : 17) : (half ? 4 : 3)] + (size_t)l * DM * FF;
            tr_item(src, FF, DM, kb * 64, pn * 128 + j0, (bf16*)(wl + (second ? WO_GU2 : WO_GU1)), n0, a.in[second ? 16 : 2] + l * DM, 1.f, scr, lane, (!second && l > 0) ? a.in[20] + (l - 1) * DM : nullptr);
            continue;
        }
        r -= I_GU;
        if (r < I_D) { const int kb = r / 32, nb = r % 32; tr_item(a.in[5] + (size_t)l * FF * DM, DM, FF, kb * 64, nb * 32, (bf16*)(wl + WO_D1), nb * 32, nullptr, 0.5f, scr, lane); continue; }
        r -= I_D;
        if (r < I_IN) {
            const int kb = r / 112, nb = r % 112, n0 = nb * 32, pn = n0 >> 8, w = n0 & 255, bj = w >> 7, q0 = w & 127, type = pn >> 1;
            int src;
            if (type <= 1) src = pn * 256 + (q0 >> 6) * 128 + bj * 64 + (q0 & 63);
            else if (type == 4 || type == 5) { const int wc = q0 >> 5; src = pn * 256 + (wc >> 1) * 128 + (wc & 1) * 64 + bj * 32; }
            else src = n0;
            tr_item(a.in[7] + (size_t)l * DM * NIN, NIN, DM, kb * 64, src, (bf16*)(wl + WO_IN), n0, a.in[6] + l * DM, type == 1 ? 0.08838834764831845f : 1.f, scr, lane);
            continue;
        }
        r -= I_IN;
        if (r < I_OUT) { const int kb = r / 32, nb = r % 32; tr_item(a.in[15] + (size_t)l * DM * DM, DM, DM, kb * 64, nb * 32, (bf16*)(wl + WO_OUT), nb * 32, nullptr, 1.f, scr, lane); continue; }
        r -= I_OUT + I_GU;
        { const int kb = r / 32, nb = r % 32; tr_item(a.in[19] + (size_t)l * FF * DM, DM, FF, kb * 64, nb * 32, (bf16*)(wl + WO_D2), nb * 32, nullptr, 0.5f, scr, lane); }
    }
    u64* stat = (u64*)(ws + WS_STAT); bf16* hb = (bf16*)(ws + WS_HB);
    for (int row0 = gw; row0 < T; row0 += 4 * NGW) {
        f32x4 v[4][4]; float sq[4];
#pragma unroll
        for (int k = 0; k < 4; ++k) {
            const int row = row0 + k * NGW;
            if (row < T) {
                const float* xr = (row < TP) ? a.in[0] + (size_t)row * DM : a.in[1] + (size_t)(row - TP) * DM;
#pragma unroll
                for (int j = 0; j < 2; ++j) { v[k][2 * j] = *(const f32x4*)(xr + 8 * lane + 512 * j); v[k][2 * j + 1] = *(const f32x4*)(xr + 8 * lane + 512 * j + 4); }
            }
        }
#pragma unroll
        for (int k = 0; k < 4; ++k) {
            const int row = row0 + k * NGW;
            if (row < T) {
                float s = 0.f;
#pragma unroll
                for (int j = 0; j < 4; ++j) s += (v[k][j][0] * v[k][j][0] + v[k][j][1] * v[k][j][1]) + (v[k][j][2] * v[k][j][2] + v[k][j][3] * v[k][j][3]);
                sq[k] = wave_sum(s);
                if (lane == 0) stat[row] = ss_fix(sq[k]);
#pragma unroll
                for (int j = 0; j < 2; ++j) { u32x4 w; w.x = pkbf(v[k][2 * j][0], v[k][2 * j][1]); w.y = pkbf(v[k][2 * j][2], v[k][2 * j][3]); w.z = pkbf(v[k][2 * j + 1][0], v[k][2 * j + 1][1]); w.w = pkbf(v[k][2 * j + 1][2], v[k][2 * j + 1][3]);
                    *(u32x4*)(hb + (size_t)row * DM + 8 * lane + 512 * j) = w; }
            }
        }
    }
    const int gt = vcu * 512 + tid, NT = G * 512;
    for (int i = gt; i < T; i += NT) { stat[1 * T + i] = 0; stat[2 * T + i] = 0; stat[3 * T + i] = 0; stat[4 * T + i] = 0; stat[5 * T + i] = 0; stat[6 * T + i] = 0; stat[7 * T + i] = 0; }
    f32x2* rot = (f32x2*)(ws + WS_ROT);
    for (int i = gt; i < SEQ * 64; i += NT) {
        const int pos = i >> 6, j = i & 63;
        const float inv = exp2f((float)(-j) * 0.20762050593046015f);
        const float ang = (float)pos * inv;
        const float fr = fmaf(ang, 0.15915494309189535f, -rintf(ang * 0.15915494309189535f));
        rot[i] = (f32x2){__builtin_amdgcn_cosf(fr), __builtin_amdgcn_sinf(fr)};
    }
}

__device__ __forceinline__ void phase_fnorm(const Args& a, unsigned char* ws, float* outp, int l, int vcu, int G, int wid, int lane) {
    const int gw = vcu * 8 + wid, NGW = G * 8;
    u64* stat = (u64*)(ws + WS_STAT); bf16* hb = (bf16*)(ws + WS_HB);
    const f32x4* gp = (const f32x4*)(a.in[20] + l * DM);
    f32x4 g[4];
#pragma unroll
    for (int j = 0; j < 4; ++j) g[j] = gp[lane + 64 * j];
    for (int row0 = gw; row0 < T; row0 += 2 * NGW) {
        f32x4 v[2][4]; float sc[2];
#pragma unroll
        for (int k = 0; k < 2; ++k) {
            const int row = row0 + k * NGW;
            if (row < T) {
                const bf16* hr = hb + (size_t)row * DM;
#pragma unroll
                for (int j = 0; j < 4; ++j) { const u32x2 w = *(const u32x2*)(hr + 4 * (lane + 64 * j)); v[k][j] = (f32x4){bflo(w.x), bfhi(w.x), bflo(w.y), bfhi(w.y)}; }
                sc[k] = ss_scale(stat + (size_t)(l * 4 + 3) * T, row);
            }
        }
#pragma unroll
        for (int k = 0; k < 2; ++k) {
            const int row = row0 + k * NGW;
            if (row < T) {
                float* hr = outp + (size_t)row * DM; float q = 0.f;
#pragma unroll
                for (int j = 0; j < 4; ++j) {
                    const f32x4 x = v[k][j] * sc[k] * g[j];
                    ((f32x4*)hr)[lane + 64 * j] = x; q += (x[0] * x[0] + x[1] * x[1]) + (x[2] * x[2] + x[3] * x[3]);
                    if (l == 0) { u32x2 w; w.x = pkbf(x[0], x[1]); w.y = pkbf(x[2], x[3]); *(u32x2*)(hb + (size_t)row * DM + 4 * (lane + 64 * j)) = w; }
                }
                if (l == 0) { q = wave_sum(q); if (lane == 0) stat[4 * T + row] = ss_fix(q); }
            }
        }
    }
}

__device__ __forceinline__ void ret_gammas(const Args& a, int l, int h, float& lgf2, float& lgb2) {
    const float xf = a.in[8][(l * 2 + 0) * 4 + h], xb = a.in[8][(l * 2 + 1) * 4 + h];
    lgf2 = -log1pf(expf(-xf)) * LOG2E; lgb2 = -log1pf(expf(-xb)) * LOG2E;
}
__device__ __forceinline__ void r1_unit(const Args& a, unsigned char* ws, bf16* STB, LAS unsigned char* lds, int l, int unit, int tid, int wid, int lane) {
    asm volatile("" : "+v"(lane), "+v"(tid));
    const int n = unit & 15, h = (unit >> 4) & 3, b = unit >> 6;
    float lgf2, lgb2; ret_gammas(a, l, h, lgf2, lgb2);
    const bf16* P = (const bf16*)(ws + WS_P);
    const bf16* kp = P + (size_t)(b * SEQ + n * 128) * NIN + 512 + h * 128;
    LAS unsigned char* KF = lds, * KB = lds + 32768, * VT = lds + 65536;
#pragma unroll
    for (int i = 0; i < 4; ++i) {
        const int c = tid + 512 * i, row = c >> 4, ch = c & 15;
        const u32x4 kv = *(const u32x4*)(kp + (size_t)row * NIN + ch * 8), vv = *(const u32x4*)(kp + 512 + (size_t)row * NIN + ch * 8);
        const float zf = __builtin_amdgcn_exp2f((float)(127 - row) * lgf2), zb = __builtin_amdgcn_exp2f((float)row * lgb2);
        u32x4 wf, wb;
#pragma unroll
        for (int e = 0; e < 4; ++e) { const float x0 = bflo(kv[e]), x1 = bfhi(kv[e]); wf[e] = pkbf(x0 * zf, x1 * zf); wb[e] = pkbf(x0 * zb, x1 * zb); }
        const unsigned o = offb(row, ch);
        *(LAS u32x4*)(KF + o) = wf; *(LAS u32x4*)(KB + o) = wb; *(LAS u32x4*)(VT + o) = vv;
    }
    __syncthreads();
    const int r32 = lane & 31, hi = lane >> 5, g1 = (lane >> 4) & 1, q4 = (lane & 15) >> 2, p4 = lane & 3;
    const int dir = wid >> 2, db = wid & 3;
    const LAS unsigned char* KS = dir ? KB : KF;
    f32x16 acc[4];
#pragma unroll
    for (int eb = 0; eb < 4; ++eb)
#pragma unroll
        for (int r = 0; r < 16; ++r) acc[eb][r] = 0.f;
    unsigned vbn[4][2];
#pragma unroll
    for (int c = 0; c < 4; ++c) { vbn[c][0] = tr_base_nat(c, 0, lane); vbn[c][1] = tr_base_nat(c, 1, lane); }
    const unsigned kb0 = tr_base_nat(db, 0, lane), kb1 = tr_base_nat(db, 1, lane);
#pragma unroll
    for (int ks = 0; ks < 8; ++ks) {
        const bf16x8 bfr = tr_pair(KS + kb0 + 256 * (16 * ks), KS + kb1 + 256 * (16 * ks + 4));
#pragma unroll
        for (int eb = 0; eb < 4; ++eb) { const bf16x8 afr = tr_pair(VT + vbn[eb][0] + 256 * (16 * ks), VT + vbn[eb][1] + 256 * (16 * ks + 4)); acc[eb] = __builtin_amdgcn_mfma_f32_32x32x16_bf16(afr, bfr, acc[eb], 0, 0, 0); }
    }
    bf16* st = STB + ((size_t)(((b * 4 + h) * 16 + n) * 2 + dir)) * 16384 + (size_t)(32 * db + r32) * 128;
#pragma unroll
    for (int eb = 0; eb < 4; ++eb)
#pragma unroll
        for (int pr = 0; pr < 2; ++pr) {
            const unsigned ax = pkbf(acc[eb][8 * pr], acc[eb][8 * pr + 1]), ay = pkbf(acc[eb][8 * pr + 2], acc[eb][8 * pr + 3]), bx = pkbf(acc[eb][8 * pr + 4], acc[eb][8 * pr + 5]), by = pkbf(acc[eb][8 * pr + 6], acc[eb][8 * pr + 7]);
            const auto sx = __builtin_amdgcn_permlane32_swap(ax, bx, false, false), sy = __builtin_amdgcn_permlane32_swap(ay, by, false, false);
            u32x4 w; w.x = sx[0]; w.y = sy[0]; w.z = sx[1]; w.w = sy[1];
            *(u32x4*)(st + 32 * eb + 16 * pr + 8 * hi) = w; }
    __syncthreads();
}
__device__ __forceinline__ void phase_scan(const Args& a, unsigned char* ws, bf16* STB, int l, int vcu, int G, int tid, int z) {
    bf16* ST = STB;
    const int gt = vcu * 512 + tid, NT = G * 512;
    for (int it = gt; it < 192 * 2 * 2048; it += NT) {
        const int grp = it & 2047, dir = (it >> 11) & 1, bh = it >> 12, h = bh & 3;
        float lgf2, lgb2; ret_gammas(a, l, h, lgf2, lgb2);
        const float g = __builtin_amdgcn_exp2f(128.f * (dir ? lgb2 : lgf2));
        bf16* base = ST + ((size_t)(bh * 16) * 2 + dir) * 16384 + grp * 8;
        u32x4 kv[16];
        const size_t cst = (size_t)(32768 + z);
#pragma unroll
        for (int n = 0; n < 16; ++n) kv[n] = *(const u32x4*)(base + (size_t)n * cst);
        float c[8];
#pragma unroll
        for (int e = 0; e < 8; ++e) c[e] = 0.f;
#pragma unroll
        for (int i = 0; i < 16; ++i) {
            const int n = dir ? 15 - i : i;
            u32x4 w; w.x = pkbf(c[0], c[1]); w.y = pkbf(c[2], c[3]); w.z = pkbf(c[4], c[5]); w.w = pkbf(c[6], c[7]);
            *(u32x4*)(base + (size_t)n * cst) = w;
#pragma unroll
            for (int e = 0; e < 4; ++e) { c[2 * e] = bflo(kv[n][e]) + g * c[2 * e]; c[2 * e + 1] = bfhi(kv[n][e]) + g * c[2 * e + 1]; }
        }
    }
}
__device__ __forceinline__ void r2_unit(const Args& a, unsigned char* ws, bf16* STB, LAS unsigned char* lds, int l, int unit, int tid, int wid, int lane, int dry) {
    asm volatile("" : "+v"(lane), "+v"(tid));
    const int n = unit & 15, h = (unit >> 4) & 3, b = unit >> 6;
    float lgf2, lgb2; ret_gammas(a, l, h, lgf2, lgb2);
    bf16* P = (bf16*)(ws + WS_P);
    const bf16* kp = P + (size_t)(b * SEQ + n * 128) * NIN + 512 + h * 128;
    const bf16* sp = STB + ((size_t)((b * 4 + h) * 16 + n) * 2) * 16384;
    LAS unsigned char* KT = lds, * VT = lds + 32768, * SF = lds + 65536, * SB = lds + 98304;
#pragma unroll
    for (int i = 0; i < 4; ++i) {
        const int c = tid + 512 * i, row = c >> 4, ch = c & 15; const unsigned o = offb(row, ch);
        const u32x4 kv = *(const u32x4*)(kp + (size_t)row * NIN + ch * 8), vv = *(const u32x4*)(kp + 512 + (size_t)row * NIN + ch * 8);
        const u32x4 sf = *(const u32x4*)(sp + row * 128 + ch * 8), sb = *(const u32x4*)(sp + 16384 + row * 128 + ch * 8);
        *(LAS u32x4*)(KT + o) = kv; *(LAS u32x4*)(VT + o) = vv; *(LAS u32x4*)(SF + o) = sf; *(LAS u32x4*)(SB + o) = sb;
    }
    const int r32 = lane & 31, hi = lane >> 5, g1 = (lane >> 4) & 1, q4 = (lane & 15) >> 2, p4 = lane & 3;
    const int cb = wid & 3, eh = wid >> 2;
    const int cl = 32 * cb + r32;
    const size_t tok = (size_t)b * SEQ + n * 128 + cl;
    bf16x8 qf[8];
#pragma unroll
    for (int kd = 0; kd < 8; ++kd) qf[kd] = *(const bf16x8*)(P + tok * NIN + h * 128 + 16 * kd + 8 * hi);
    __syncthreads();
    f32x16 O[2], XF[2], XB[2];
#pragma unroll
    for (int e = 0; e < 2; ++e)
#pragma unroll
        for (int r = 0; r < 16; ++r) { O[e][r] = 0.f; XF[e][r] = 0.f; XB[e][r] = 0.f; }
    float ff[16], fb[16];
#pragma unroll
    for (int r = 0; r < 16; ++r) { ff[r] = __builtin_amdgcn_exp2f((float)(31 - crow(r, hi)) * lgf2); fb[r] = __builtin_amdgcn_exp2f((float)crow(r, hi) * lgb2); }
    unsigned vp[2][2], sn[2][2], kb[8];
#pragma unroll
    for (int e = 0; e < 2; ++e)
#pragma unroll
        for (int tt = 0; tt < 2; ++tt) { vp[e][tt] = tr_base_perm(2 * eh + e, tt, lane); sn[e][tt] = tr_base_nat(2 * eh + e, tt, lane); }
#pragma unroll
    for (int kd = 0; kd < 8; ++kd) kb[kd] = row_base(2 * kd, lane);
#pragma unroll
    for (int mb = 0; mb < 4; ++mb) {
        f32x16 S;
#pragma unroll
        for (int r = 0; r < 16; ++r) S[r] = 0.f;
#pragma unroll
        for (int kd = 0; kd < 8; ++kd) { const bf16x8 kf = *(const LAS bf16x8*)(KT + kb[kd] + 8192 * mb); S = __builtin_amdgcn_mfma_f32_32x32x16_bf16(kf, qf[kd], S, 0, 0, 0); }
        if (mb < cb) { const float fa = __builtin_amdgcn_exp2f((float)(cl - 32 * mb - 31) * lgf2);
#pragma unroll
            for (int r = 0; r < 16; ++r) S[r] *= fa * ff[r];
        } else if (mb > cb) { const float fa = __builtin_amdgcn_exp2f((float)(32 * mb - cl) * lgb2);
#pragma unroll
            for (int r = 0; r < 16; ++r) S[r] *= fa * fb[r];
        } else {
#pragma unroll
            for (int r = 0; r < 16; ++r) { const int rel = r32 - crow(r, hi); const float d = (rel >= 0) ? (float)rel * lgf2 : (float)(-rel) * lgb2; S[r] *= __builtin_amdgcn_exp2f(d); }
        }
#pragma unroll
        for (int s = 0; s < 2; ++s) {
            const bf16x8 pk = pack8(S, s);
#pragma unroll
            for (int e = 0; e < 2; ++e) { const bf16x8 vf = tr_pair(VT + vp[e][0] + 256 * (32 * mb + 16 * s), VT + vp[e][1] + 256 * (32 * mb + 16 * s + 8)); O[e] = __builtin_amdgcn_mfma_f32_32x32x16_bf16(vf, pk, O[e], 0, 0, 0); }
        }
    }
#pragma unroll
    for (int kd = 0; kd < 8; ++kd) {
#pragma unroll
        for (int e = 0; e < 2; ++e) {
            const bf16x8 ff = tr_pair(SF + sn[e][0] + 256 * (16 * kd), SF + sn[e][1] + 256 * (16 * kd + 4)); XF[e] = __builtin_amdgcn_mfma_f32_32x32x16_bf16(ff, qf[kd], XF[e], 0, 0, 0);
            const bf16x8 fb = tr_pair(SB + sn[e][0] + 256 * (16 * kd), SB + sn[e][1] + 256 * (16 * kd + 4)); XB[e] = __builtin_amdgcn_mfma_f32_32x32x16_bf16(fb, qf[kd], XB[e], 0, 0, 0);
        }
    }
    const float xf = __builtin_amdgcn_exp2f((float)(cl + 1) * lgf2), xb = __builtin_amdgcn_exp2f((float)(128 - cl) * lgb2);
    float s1 = 0.f, s2 = 0.f;
#pragma unroll
    for (int e = 0; e < 2; ++e)
#pragma unroll
        for (int r = 0; r < 16; ++r) { const float o = O[e][r] + xf * XF[e][r] + xb * XB[e][r]; O[e][r] = o; s1 += o; s2 += o * o; }
    s1 += __shfl_xor(s1, 32); s2 += __shfl_xor(s2, 32);
    LAS f32x2* stt = (LAS f32x2*)(lds + LDS_STATS);
    if (hi == 0) stt[eh * 128 + cl] = (f32x2){s1, s2};
    __syncthreads();
    const f32x2 o2 = stt[(eh ^ 1) * 128 + cl];
    const float mu = (s1 + o2[0]) * (1.f / 128.f), var = (s2 + o2[1]) * (1.f / 128.f) - mu * mu, rstd = __builtin_amdgcn_rsqf(fmaxf(var, 0.f) + EPS);
    const float* gg = a.in[9] + l * 512 + h * 128;
    bf16* gp = P + tok * NIN + 1536 + h * 128;
#pragma unroll
    for (int e = 0; e < 2; ++e)
#pragma unroll
        for (int pr = 0; pr < 2; ++pr) {
            unsigned wv[2][2];
#pragma unroll
            for (int k = 0; k < 2; ++k) {
                const int rq = 2 * pr + k, e0 = 64 * eh + 32 * e + 8 * rq + 4 * hi;
                const u32x2 sg = *(const u32x2*)(gp + e0); const f32x4 gv = *(const f32x4*)(gg + e0);
                const float y0 = (O[e][4 * rq + 0] - mu) * rstd * gv[0] * bflo(sg.x), y1 = (O[e][4 * rq + 1] - mu) * rstd * gv[1] * bfhi(sg.x);
                const float y2 = (O[e][4 * rq + 2] - mu) * rstd * gv[2] * bflo(sg.y), y3 = (O[e][4 * rq + 3] - mu) * rstd * gv[3] * bfhi(sg.y);
                wv[k][0] = pkbf(y0, y1); wv[k][1] = pkbf(y2, y3);
            }
            const auto sx = __builtin_amdgcn_permlane32_swap(wv[0][0], wv[1][0], false, false), sy = __builtin_amdgcn_permlane32_swap(wv[0][1], wv[1][1], false, false);
            u32x4 w; w.x = sx[0]; w.y = sy[0]; w.z = sx[1]; w.w = sy[1];
            if (!dry) *(u32x4*)(gp + 64 * eh + 32 * e + 16 * pr + 8 * hi) = w;
        }
    __syncthreads();
}

__device__ __forceinline__ void dattn_setup(const Args& a, LAS unsigned char* lds, int l, int tid, int lane) {
    const float* qg = a.in[10] + l * 128, * kg = a.in[11] + l * 128, * tb = a.in[14], * lv = a.in[12] + l * 256;
    const float mq = wave_max(fmaxf(fabsf(qg[lane]), fabsf(qg[64 + lane]))), mk = wave_max(fmaxf(fabsf(kg[lane]), fabsf(kg[64 + lane])));
    const float mb = wave_max(fmaxf(tb[lane], tb[64 + lane]));
    const float M = 8.f * mq * mk + mb;
    const float s0 = wave_sum(lv[lane] * lv[64 + lane]), s1 = wave_sum(lv[128 + lane] * lv[192 + lane]);
    const float lam_init = 0.8f - 0.6f * expf(-0.3f * (float)l);
    const float lam = expf(s0) - expf(s1) + lam_init;
    LAS float* tab = (LAS float*)(lds + LDS_TAB); LAS float* misc = (LAS float*)(lds + LDS_MISC);
    for (int i = tid; i < 4 * 321; i += 512) { const int h = i / 321, k = i % 321; tab[i] = (tb[rel_bucket(k - 160) * 4 + h] - M) * LOG2E; }
    if (tid == 0) { misc[0] = lam; misc[1] = 1.f - lam_init; }
    __syncthreads();
}
#define DA_LOAD(kt) do { _Pragma("unroll") for (int i_ = 0; i_ < 2; ++i_) { const int c_ = tid + 512 * i_, row_ = c_ >> 4, ch_ = c_ & 15; \
        kr[i_] = *(const u32x4*)(kbase + (size_t)((kt) * 64 + row_) * NIN + ch_ * 8); vr[i_] = *(const u32x4*)(kbase + 512 + (size_t)((kt) * 64 + row_) * NIN + ch_ * 8); } } while (0)
#define DA_STORE(buf) do { _Pragma("unroll") for (int i_ = 0; i_ < 2; ++i_) { const int c_ = tid + 512 * i_, row_ = c_ >> 4, ch_ = c_ & 15; const unsigned o_ = offb(row_, ch_); \
        *(LAS u32x4*)(lds + (buf) * 32768 + o_) = kr[i_]; *(LAS u32x4*)(lds + (buf) * 32768 + 16384 + o_) = vr[i_]; } } while (0)
__device__ __forceinline__ void dattn_unit(const Args& a, unsigned char* ws, LAS unsigned char* lds, int l, int unit, int tid, int wid, int lane, int dry) {
    asm volatile("" : "+v"(lane), "+v"(tid));
    const int qb = unit & 15, h = (unit >> 4) & 3, b = unit >> 6;
    const int r32 = lane & 31, hi = lane >> 5, g1 = (lane >> 4) & 1, q4 = (lane & 15) >> 2, p4 = lane & 3;
    const int t = wid & 1, rg = wid >> 1;
    const int qw = qb * 128 + rg * 32;
    bf16* P = (bf16*)(ws + WS_P);
    const size_t tok = (size_t)b * SEQ + qw + r32;
    const LAS float* tab = (const LAS float*)(lds + LDS_TAB) + h * 321;
    const LAS float* misc = (const LAS float*)(lds + LDS_MISC);
    bf16x8 qf[4];
#pragma unroll
    for (int d0 = 0; d0 < 4; ++d0) qf[d0] = *(const bf16x8*)(P + tok * NIN + 2048 + h * 128 + t * 64 + 16 * d0 + 8 * hi);
    const bf16* kbase = P + (size_t)b * SEQ * NIN + 2560 + h * 128;
    f32x16 O[4];
#pragma unroll
    for (int eb = 0; eb < 4; ++eb)
#pragma unroll
        for (int r = 0; r < 16; ++r) O[eb][r] = 0.f;
    float lsum = 0.f;
    const float bneg = tab[0], bpos = tab[320];
    unsigned vp[4][2], kb[4];
#pragma unroll
    for (int c = 0; c < 4; ++c) { vp[c][0] = tr_base_perm(c, 0, lane); vp[c][1] = tr_base_perm(c, 1, lane); kb[c] = row_base(8 * t + 2 * c, lane); }
    const int rot = 2 * qb;
    int dsrc[2];
#pragma unroll
    for (int i = 0; i < 2; ++i) { const int p = (2 * wid + i) * 64 + lane, row = p >> 4, ch = (p & 15) ^ (((row & 3) << 2) | ((row >> 2) & 3)); dsrc[i] = row * NIN + ch * 8; }
#define DA_DMAK(kt, slot) do { _Pragma("unroll") for (int i_ = 0; i_ < 2; ++i_) __builtin_amdgcn_global_load_lds((const unsigned*)(kbase + (size_t)((((kt) + rot) & 31) * 64) * NIN + dsrc[i_]), \
        (LAS unsigned*)(lds + (slot) * 32768 + (2 * wid + i_) * 1024), 16, 0, 0); } while (0)
#define DA_DMAV(kt, slot) do { _Pragma("unroll") for (int i_ = 0; i_ < 2; ++i_) __builtin_amdgcn_global_load_lds((const unsigned*)(kbase + 512 + (size_t)((((kt) + rot) & 31) * 64) * NIN + dsrc[i_]), \
        (LAS unsigned*)(lds + (slot) * 32768 + 16384 + (2 * wid + i_) * 1024), 16, 0, 0); } while (0)
#define DA_WAITBAR() asm volatile("s_waitcnt vmcnt(0) lgkmcnt(0)\n\ts_barrier" ::: "memory")
#define DA_QK(kt, slot, SN) do { \
        const LAS unsigned char* KT_ = lds + (slot) * 32768; \
        bf16x8 kf_[2][4]; \
        _Pragma("unroll") for (int blk = 0; blk < 2; ++blk) _Pragma("unroll") for (int d0 = 0; d0 < 4; ++d0) kf_[blk][d0] = *(const LAS bf16x8*)(KT_ + kb[d0] + 8192 * blk); \
        _Pragma("unroll") for (int blk = 0; blk < 2; ++blk) { \
            const int k0_ = (((kt) + rot) & 31) * 64 + blk * 32, relmax_ = k0_ + 31 - qw, relmin_ = k0_ - qw - 31; \
            const float cinit_ = (relmax_ <= -91) ? bneg : ((relmin_ >= 91) ? bpos : 0.f); \
            _Pragma("unroll") for (int r = 0; r < 16; ++r) SN[blk][r] = cinit_; \
            _Pragma("unroll") for (int d0 = 0; d0 < 4; ++d0) SN[blk] = __builtin_amdgcn_mfma_f32_32x32x16_bf16(kf_[blk][d0], qf[d0], SN[blk], 0, 0, 0); \
        } } while (0)
#define DA_SB() __builtin_amdgcn_sched_barrier(0)
#define DA_VRD(blk, j) tr_pair(VT_ + vp[(j) & 3][0] + 256 * (32 * (blk) + 16 * ((j) >> 2)), VT_ + vp[(j) & 3][1] + 256 * (32 * (blk) + 16 * ((j) >> 2) + 8))
#define DA_STEP(kt, par, SC, SN, HAS_K2, HAS_V1, HAS_QK) do { \
        if (HAS_K2) DA_DMAK((kt) + 2, par); \
        if (HAS_V1) DA_DMAV((kt) + 1, (par) ^ 1); \
        const LAS unsigned char* KT_ = lds + ((par) ^ 1) * 32768; const LAS unsigned char* VT_ = lds + (par) * 32768 + 16384; \
        bf16x8 kf_[2][4], vf_[8]; \
        if (HAS_QK) { \
            _Pragma("unroll") for (int blk = 0; blk < 2; ++blk) _Pragma("unroll") for (int d0 = 0; d0 < 4; ++d0) kf_[blk][d0] = *(const LAS bf16x8*)(KT_ + kb[d0] + 8192 * blk); \
            _Pragma("unroll") for (int blk = 0; blk < 2; ++blk) { \
                const int k0_ = (((kt) + 1 + rot) & 31) * 64 + blk * 32, relmax_ = k0_ + 31 - qw, relmin_ = k0_ - qw - 31; \
                const float cinit_ = (relmax_ <= -91) ? bneg : ((relmin_ >= 91) ? bpos : 0.f); \
                _Pragma("unroll") for (int r = 0; r < 16; ++r) SN[blk][r] = cinit_; } \
        } \
        _Pragma("unroll") for (int blk = 0; blk < 2; ++blk) { \
            const int k0_ = (((kt) + rot) & 31) * 64 + blk * 32, relmax_ = k0_ + 31 - qw, relmin_ = k0_ - qw - 31; \
            if (!(relmax_ <= -91 || relmin_ >= 91)) { \
                const LAS float* tb_ = tab + (k0_ - qw - r32 + 4 * hi + 160);     \
                _Pragma("unroll") for (int r = 0; r < 16; ++r) SC[blk][r] += tb_[(r & 3) + 8 * (r >> 2)]; \
            } } \
        DA_SB(); \
        _Pragma("unroll") for (int j = 0; j < 8; ++j) { \
            if (HAS_QK) SN[j >> 2] = __builtin_amdgcn_mfma_f32_32x32x16_bf16(kf_[j >> 2][j & 3], qf[j & 3], SN[j >> 2], 0, 0, 0); \
            SC[0][2 * j] = __builtin_amdgcn_exp2f(SC[0][2 * j]); SC[0][2 * j + 1] = __builtin_amdgcn_exp2f(SC[0][2 * j + 1]); \
            vf_[j] = DA_VRD(0, j); \
            DA_SB(); } \
        const bf16x8 pk00_ = pack8(SC[0], 0), pk01_ = pack8(SC[0], 1); \
        DA_SB(); \
        _Pragma("unroll") for (int j = 0; j < 8; ++j) { \
            O[j & 3] = __builtin_amdgcn_mfma_f32_32x32x16_bf16(vf_[j], (j >> 2) ? pk01_ : pk00_, O[j & 3], 0, 0, 0); \
            SC[1][2 * j] = __builtin_amdgcn_exp2f(SC[1][2 * j]); SC[1][2 * j + 1] = __builtin_amdgcn_exp2f(SC[1][2 * j + 1]); \
            lsum += SC[0][2 * j] + SC[0][2 * j + 1]; \
            vf_[j] = DA_VRD(1, j); \
            DA_SB(); } \
        const bf16x8 pk10_ = pack8(SC[1], 0), pk11_ = pack8(SC[1], 1); \
        DA_SB(); \
        _Pragma("unroll") for (int j = 0; j < 8; ++j) { \
            O[j & 3] = __builtin_amdgcn_mfma_f32_32x32x16_bf16(vf_[j], (j >> 2) ? pk11_ : pk10_, O[j & 3], 0, 0, 0); \
            lsum += SC[1][2 * j] + SC[1][2 * j + 1]; \
            DA_SB(); } \
        DA_WAITBAR(); } while (0)
    f32x16 SA[2], SB[2];
    DA_DMAK(0, 0); DA_DMAV(0, 0); DA_DMAK(1, 1);
    DA_WAITBAR();
    DA_QK(0, 0, SA);
    DA_WAITBAR();
    for (int kt = 0; kt < 30; kt += 2) { DA_STEP(kt, 0, SA, SB, true, true, true); DA_STEP(kt + 1, 1, SB, SA, true, true, true); }
    DA_STEP(30, 0, SA, SB, false, true, true);
    DA_STEP(31, 1, SB, SA, false, false, false);
#undef DA_SB
#undef DA_VRD
#undef DA_STEP
#undef DA_QK
#undef DA_DMAK
#undef DA_DMAV
#undef DA_WAITBAR
    lsum += __shfl_xor(lsum, 32);
    const float lam = misc[0], oneml = misc[1];
    LAS float* Y = (LAS float*)lds + rg * 4096;
    if (t == 1) {
        const float inv = lam / lsum;
#pragma unroll
        for (int eb = 0; eb < 4; ++eb)
#pragma unroll
            for (int r = 0; r < 16; ++r) Y[(32 * eb + crow(r, hi)) * 32 + r32] = O[eb][r] * inv;
    }
    __syncthreads();
    if (t == 0 && !dry) {
        const float inv = 1.f / lsum; float ssq = 0.f;
#pragma unroll
        for (int eb = 0; eb < 4; ++eb)
#pragma unroll
            for (int r = 0; r < 16; ++r) { const float o = O[eb][r] * inv - Y[(32 * eb + crow(r, hi)) * 32 + r32]; O[eb][r] = o; ssq += o * o; }
        ssq += __shfl_xor(ssq, 32);
        const float rs = __builtin_amdgcn_rsqf(ssq * (1.f / 128.f) + EPS) * oneml;
        const float* sg = a.in[13] + l * 128;
        bf16* op = P + tok * NIN + 2048 + h * 128;
#pragma unroll
        for (int eb = 0; eb < 4; ++eb)
#pragma unroll
            for (int pr = 0; pr < 2; ++pr) {
                u32x2 wa, wb;
                { const int rq = 2 * pr, e0 = 32 * eb + 8 * rq + 4 * hi; const f32x4 gv = *(const f32x4*)(sg + e0);
                  wa.x = pkbf(O[eb][4 * rq] * rs * gv[0], O[eb][4 * rq + 1] * rs * gv[1]); wa.y = pkbf(O[eb][4 * rq + 2] * rs * gv[2], O[eb][4 * rq + 3] * rs * gv[3]); }
                { const int rq = 2 * pr + 1, e0 = 32 * eb + 8 * rq + 4 * hi; const f32x4 gv = *(const f32x4*)(sg + e0);
                  wb.x = pkbf(O[eb][4 * rq] * rs * gv[0], O[eb][4 * rq + 1] * rs * gv[1]); wb.y = pkbf(O[eb][4 * rq + 2] * rs * gv[2], O[eb][4 * rq + 3] * rs * gv[3]); }
                const auto sx = __builtin_amdgcn_permlane32_swap(wa.x, wb.x, false, false), sy = __builtin_amdgcn_permlane32_swap(wa.y, wb.y, false, false);
                u32x4 w; w.x = sx[0]; w.y = sy[0]; w.z = sx[1]; w.w = sy[1];
                *(u32x4*)(op + 32 * eb + 16 * pr + 8 * hi) = w;
            }
    }
    __syncthreads();
}

#define XB_TMO      128
#define XB_XCNT(j)  (256  + 64 * (j))
#define XB_XSUB(j)  (1280 + 64 * (j))
#define XB_XGEN(j)  (2304 + 64 * (j))
#define XB_TOP      3328
#define XB_TOPGEN   3392
#define XCD_BAR_WORDS 3456
#define XB_SPIN_CAP (1u << 18)

__device__ __forceinline__ unsigned xb_ld(unsigned* p)              { return __hip_atomic_load(p, __ATOMIC_RELAXED, __HIP_MEMORY_SCOPE_AGENT); }
__device__ __forceinline__ unsigned xb_add(unsigned* p, unsigned v) { return __hip_atomic_fetch_add(p, v, __ATOMIC_RELAXED, __HIP_MEMORY_SCOPE_AGENT); }
__device__ __forceinline__ unsigned xb_xcc_id() { return (unsigned)__builtin_amdgcn_s_getreg((3 << 11) | 20) & 0xFu; }
#define XB_SPIN(cond, bar) do { unsigned _sp = 0; while (cond) { __builtin_amdgcn_s_sleep(1); \
    if ((++_sp & 255u) == 0u) { if (xb_ld(&(bar)[XB_TMO])) break; if (_sp > XB_SPIN_CAP) { atomicAdd(&(bar)[XB_TMO], 1u); break; } } } } while (0)

struct XcdBarrier {
    unsigned* bar; unsigned x;
    volatile LAS unsigned* st;
};

__device__ __forceinline__ XcdBarrier xcd_barrier_post(unsigned* bar, volatile LAS unsigned* st) {
    XcdBarrier b; b.bar = bar; b.x = xb_xcc_id(); b.st = st;
    if (threadIdx.x == 0) (void)xb_add(&bar[XB_XCNT(b.x)], 1u);
    return b;
}
__device__ __forceinline__ void xcd_barrier_complete(unsigned* bar, unsigned x, unsigned& nloc, unsigned& nx) {
    const unsigned G = gridDim.x * gridDim.y * gridDim.z;
    unsigned sum, cnt, mine, sp = 0u;
    for (;;) {
        sum = 0u; cnt = 0u; mine = 0u;
#pragma unroll
        for (unsigned j = 0; j < 16; ++j) { const unsigned c = xb_ld(&bar[XB_XCNT(j)]); sum += c; cnt += (c > 0u) ? 1u : 0u; mine = (j == x) ? c : mine; }
        if (sum == G) break;
        __builtin_amdgcn_s_sleep(1);
        if ((++sp & 255u) == 0u) { if (xb_ld(&bar[XB_TMO])) break; if (sp > XB_SPIN_CAP) { atomicAdd(&bar[XB_TMO], 1u); break; } }
    }
    nloc = mine > 0u ? mine : 1u; nx = cnt > 0u ? cnt : 1u;
}

__device__ __forceinline__ void xcd_barrier(const XcdBarrier& b) {
    asm volatile("s_waitcnt vmcnt(0)" ::: "memory");
    __syncthreads();
    if (threadIdx.x == 0) {
        unsigned* bar = b.bar;
        __builtin_amdgcn_s_waitcnt(0);
        unsigned nloc = b.st[0], nx = b.st[1];
        if (nloc == 0u) { xcd_barrier_complete(bar, b.x, nloc, nx); b.st[0] = nloc; b.st[1] = nx; }
        const unsigned old = xb_add(&bar[XB_XSUB(b.x)], 1u);
        const unsigned gen = old / nloc;
        if (old + 1u == (gen + 1u) * nloc) {
            __builtin_amdgcn_fence(__ATOMIC_RELEASE, "agent");
            asm volatile("s_waitcnt vmcnt(0)" ::: "memory");
            const unsigned og = xb_add(&bar[XB_TOP], 1u);
            const unsigned tg = og / nx;
            if (og + 1u == (tg + 1u) * nx) xb_add(&bar[XB_TOPGEN], 1u);
            else XB_SPIN(xb_ld(&bar[XB_TOPGEN]) == tg, bar);
            __builtin_amdgcn_fence(__ATOMIC_ACQUIRE, "agent");
            xb_add(&bar[XB_XGEN(b.x)], 1u);
            asm volatile("s_waitcnt vmcnt(0)" ::: "memory");
        } else {
            XB_SPIN(xb_ld(&bar[XB_XGEN(b.x)]) == gen, bar);
            __builtin_amdgcn_fence(__ATOMIC_ACQUIRE, "agent");
            asm volatile("s_waitcnt vmcnt(0)" ::: "memory");
        }
    }
    __syncthreads();
}

#ifndef PROBE_DUP
#define PROBE_DUP 0
#endif
template <int PHM, int PH> __device__ __forceinline__ void run_phase(const Args& a, LAS unsigned char* lds0, int dry) {
    int tid = threadIdx.x; asm volatile("" : "+v"(tid));
    const int lane = tid & 63, wid = __builtin_amdgcn_readfirstlane(tid >> 6);
    int z_; asm volatile("s_mov_b32 %0, 0" : "=s"(z_));
    unsigned char* ws = a.ws + z_;
    LAS unsigned char* lds = lds0 + z_;
    const int G = (int)gridDim.x + z_, bx = (int)blockIdx.x + z_;
    const int vcu = (G % 8 == 0) ? (bx % 8) * (G / 8) + bx / 8 : bx;
    float* outp = (float*)((unsigned char*)a.out + z_);
    u64* stat = (u64*)(ws + WS_STAT); bf16* hb = (bf16*)(ws + WS_HB); bf16* P = (bf16*)(ws + WS_P);
    if constexpr (PH == 0) { if constexpr ((PHM & 1) != 0) phase_prep(a, ws, lds, vcu, G, tid, wid, lane); }
    else {
        constexpr int l = (PH - 1) / 10, sp = (PH - 1) % 10;
        unsigned char* wl = ws + WS_W + (size_t)l * W_LAYER;
        if constexpr ((PHM & 2) != 0 && (sp == 0 || sp == 7)) {
            pg8::Gemm g{hb, (const bf16*)(wl + (sp == 0 ? WO_GU1 : WO_GU2)), T, 2 * FF, DM, DM};
            pg8::StaticOrder S; S.init(T, 2 * FF, G, bx);
            constexpr bool NN = (l > 0 && sp == 0);
            EpiSwiGLU<NN> E{P, stat + (size_t)(NN ? (l - 1) * 4 + 3 : l * 4 + (sp == 0 ? 0 : 2)) * T, stat + (size_t)(l * 4) * T};
            pg8::gemm_phase<EpiSwiGLU<NN>, pg8::StaticOrder, true, true>(lds, g, S, E, tid);
        } else if constexpr ((PHM & 4) != 0 && (sp == 1 || sp == 8 || sp == 6)) {
            pg8::Gemm g{sp == 6 ? P + 1536 : P, (const bf16*)(wl + (sp == 1 ? WO_D1 : (sp == 8 ? WO_D2 : WO_OUT))), T, DM, sp == 6 ? DM : FF, sp == 6 ? NIN : FF};
            pg8::StaticOrder S; S.init(T, DM, G, bx);
            constexpr int MODE = (sp == 8 && l + 1 < 2) ? 1 : ((sp == 1 && l > 0) ? 2 : 0);
            constexpr int lg = (MODE == 1) ? l : (l > 0 ? l - 1 : 0);
            constexpr bool WF32 = false;
            EpiRes<MODE, WF32> E{outp, hb, stat + (size_t)(l * 4 + (sp == 1 ? 1 : (sp == 6 ? 2 : 3))) * T, dry,
                           a.in[20] + lg * DM, stat + (size_t)(lg * 4 + 3) * T, stat + (size_t)((l + 1) * 4) * T};
            pg8::gemm_phase<EpiRes<MODE, WF32>, pg8::StaticOrder, true, true>(lds, g, S, E, tid);
        } else if constexpr ((PHM & 8) != 0 && sp == 2) {
            pg8::Gemm g{hb, (const bf16*)(wl + WO_IN), T, NIN, DM, DM};
            pg8::StaticOrder S; S.init(T, NIN, G, bx);
            EpiWin E{P, stat + (size_t)(l * 4 + 1) * T, (const f32x2*)(ws + WS_ROT), a.in[10] + l * 128, a.in[11] + l * 128};
            pg8::gemm_phase<EpiWin, pg8::StaticOrder, true, true>(lds, g, S, E, tid);
        } else if constexpr ((PHM & 16) != 0 && sp == 3) {
            for (int u = vcu; u < NB * 64; u += G) r1_unit(a, ws, (bf16*)outp, lds, l, u, tid, wid, lane);
        } else if constexpr ((PHM & 32) != 0 && sp == 4) {
            phase_scan(a, ws, (bf16*)outp, l, vcu, G, tid, z_);
        } else if constexpr (sp == 5) {
            if constexpr ((PHM & 64) != 0) { dattn_setup(a, lds, l, tid, lane);
                for (int u = vcu; u < NB * 64; u += G) dattn_unit(a, ws, lds, l, u, tid, wid, lane, dry); }
            if constexpr ((PHM & 128) != 0) { for (int u = vcu; u < NB * 64; u += G) r2_unit(a, ws, (bf16*)outp, lds, l, u, tid, wid, lane, dry); }
        } else if constexpr ((PHM & 256) != 0 && sp == 9 && l == 1) {
            phase_fnorm(a, ws, outp, l, vcu, G, wid, lane);
        }
    }
}
template <int PHM> __global__ void __launch_bounds__(512) fwd_kernel(Args a0) {
    extern __shared__ __attribute__((aligned(16))) unsigned char lds_raw[];
    LAS unsigned char* lds0 = (LAS unsigned char*)lds_raw;
    cg::grid_group grid = cg::this_grid();
    const int lo = a0.lo, hi = a0.hi;
    if (threadIdx.x < 2) ((LAS unsigned*)(lds0 + LDS_BARW))[threadIdx.x] = 0u;
    __syncthreads();
    XcdBarrier xbar; xbar.bar = (unsigned*)(a0.ws + WS_BAR); xbar.x = 0; xbar.st = (volatile LAS unsigned*)(lds0 + LDS_BARW);
    if (hi - lo > 1) xbar = xcd_barrier_post((unsigned*)(a0.ws + WS_BAR), (volatile LAS unsigned*)(lds0 + LDS_BARW));
#define RUN(k) if ((k) != 10 && lo <= (k) && (k) < hi) { run_phase<PHM, (k)>(a0, lds0, a0.dry); if ((k) + 1 < hi) { if ((k) == 0) grid.sync(); else xcd_barrier(xbar); } }
    RUN(0) RUN(1) RUN(2) RUN(3) RUN(4) RUN(5) RUN(6) RUN(7) RUN(8) RUN(9) RUN(10)
    RUN(11) RUN(12) RUN(13) RUN(14) RUN(15) RUN(16) RUN(17) RUN(18) RUN(19) RUN(20)
#undef RUN
}

#ifndef N_LAUNCH_MODE
#define N_LAUNCH_MODE 1
#endif
template <int PHM> static void launch_one(const Args& a, int grid, hipStream_t stream) { hipLaunchKernelGGL(fwd_kernel<PHM>, dim3(grid), dim3(512), LDS_BYTES, stream, a); }
template <int PHM> static void set_lds() { (void)hipFuncSetAttribute((const void*)fwd_kernel<PHM>, hipFuncAttributeMaxDynamicSharedMemorySize, LDS_BYTES); }
extern "C" void kernel_launch(void* const* d_in, const int* in_sizes, int n_in, void* d_out, int out_size, void* d_ws, size_t ws_size, hipStream_t stream) {
    static int grid = 0;
    if (grid == 0) {
        if (n_in != 21 || ws_size < WS_END) { fprintf(stderr, "kernel_launch: unexpected inputs (n_in %d, ws %zu)\n", n_in, ws_size); grid = -1; return; }
        int dev = 0, cus = 0, per_cu = 0;
        (void)hipGetDevice(&dev); (void)hipDeviceGetAttribute(&cus, hipDeviceAttributeMultiprocessorCount, dev);
#if N_LAUNCH_MODE == 1
        set_lds<511>();
        (void)hipOccupancyMaxActiveBlocksPerMultiprocessor(&per_cu, (const void*)fwd_kernel<511>, 512, LDS_BYTES);
#else
        set_lds<1>(); set_lds<2>(); set_lds<4>(); set_lds<8>(); set_lds<16>(); set_lds<32>(); set_lds<64>(); set_lds<128>(); set_lds<256>();
        per_cu = 1;
#endif
        if (per_cu < 1) { fprintf(stderr, "kernel_launch: occupancy query returned %d\n", per_cu); per_cu = 1; }
        (void)hipGetLastError();
        grid = cus * per_cu;
    }
    if (grid < 0) return;
    Args a{};
    for (int i = 0; i < 21; ++i) a.in[i] = (const float*)d_in[i];
    a.out = (float*)d_out; a.ws = (unsigned char*)d_ws;
#if N_LAUNCH_MODE == 1
    (void)hipMemsetAsync((unsigned char*)d_ws + WS_BAR, 0, WS_BAR_BYTES, stream);
    a.lo = 0; a.hi = NPHASE;
    void* args[] = {&a};
    hipError_t e = hipLaunchCooperativeKernel((const void*)fwd_kernel<511>, dim3(grid), dim3(512), args, LDS_BYTES, stream);
    if (e != hipSuccess) fprintf(stderr, "cooperative launch failed: %s (grid %d)\n", hipGetErrorString(e), grid);
#else
    for (int ph = 0; ph < NPHASE; ++ph) {
        a.lo = ph; a.hi = ph + 1;
        const int sp = ph == 0 ? 11 : (ph - 1) % 10;
        const int nrep = 1 + ((PROBE_DUP >> sp) & 1), nrepB = 1 + ((PROBE_DUP >> 10) & 1);
        for (int rep = 0; rep < nrep; ++rep) {
            a.dry = (rep + 1 < nrep) ? 1 : 0;
            if (ph == 0) launch_one<1>(a, grid, stream);
            else if (sp == 0 || sp == 7) launch_one<2>(a, grid, stream);
            else if (sp == 1 || sp == 8 || sp == 6) launch_one<4>(a, grid, stream);
            else if (sp == 2) launch_one<8>(a, grid, stream);
            else if (sp == 3) launch_one<16>(a, grid, stream);
            else if (sp == 4) launch_one<32>(a, grid, stream);
            else if (sp == 5) { launch_one<64>(a, grid, stream); if (rep == 0) for (int rb = 0; rb < nrepB; ++rb) { Args b = a; b.dry = (rb + 1 < nrepB) ? 1 : 0; launch_one<128>(b, grid, stream); } }
            else launch_one<256>(a, grid, stream);
        }
    }
#endif
}
```

```cpp
#include <hip/hip_runtime.h>
#include <hip/hip_cooperative_groups.h>
#include <cstdio>
#include <cstdint>
namespace cg = cooperative_groups;
namespace pg8 {
#define PG8_LAS __attribute__((address_space(3)))
typedef unsigned short bf16_t;
typedef short bf16x8 __attribute__((ext_vector_type(8)));
typedef float f32x4 __attribute__((ext_vector_type(4)));
typedef unsigned u32x4 __attribute__((ext_vector_type(4)));
constexpr int BM = 256, BK = 64, HALF = 128, HTB = HALF * BK * 2  , STAGE_BYTES = 8 * HTB, NXCD = 8, WGM = 8;

__host__ __device__ __forceinline__ int lds_byte(int r, int c) { const int st = (r >> 4) * 2 + (c >> 5), rr = r & 15, cc = c & 31, ob = rr * 64 + cc * 2; return st * 1024 + (ob ^ (((ob >> 9) & 1) << 5)); }
__host__ __device__ __forceinline__ void stage_rc(int b, int& R, int& C) { const int st = b / 1024, sb = b % 1024, swz = sb ^ (((sb >> 9) & 1) << 5); R = (st >> 1) * 16 + swz / 64; C = (st & 1) * 32 + (swz % 64) / 2; }
__host__ __device__ __forceinline__ int perm32(int rho) { const int n = rho >> 4, i = rho & 15; return 8 * (i >> 2) + 4 * n + (i & 3); }

struct Unit { int pm, pn; };
struct Gemm { const bf16_t* A; const bf16_t* Bt; int M, N, K, lda; };

struct StaticOrder {
    int nM, nN, nwg, G, c;
    __host__ __device__ void init(int M, int N, int G_, int c_) { nM = M / BM; nN = N / BM; nwg = nM * nN; G = G_; c = c_; }
    __host__ __device__ bool next(int i, Unit& u) const {
        const long L = (long)i * G + c; if (L >= nwg) return false;
        int wgid = (int)L; { const int q = nwg / NXCD, r = nwg % NXCD, xcd = wgid % NXCD, off = wgid / NXCD; wgid = (xcd < r ? xcd * (q + 1) : r * (q + 1) + (xcd - r) * q) + off; }
        const int nig = WGM * nN, gid = wgid / nig, fm = gid * WGM, gsz = (nM - fm) < WGM ? (nM - fm) : WGM;
        u.pm = fm + ((wgid % nig) % gsz); u.pn = (wgid % nig) / gsz; return true;
    }
    __device__ __forceinline__ void a_ready(const Unit&) const {}
    __device__ __forceinline__ void done(const Unit&) const {}
};

__device__ __forceinline__ unsigned cvt_pk_bf16(float lo, float hi) { unsigned r; asm volatile("v_cvt_pk_bf16_f32 %0, %1, %2" : "=v"(r) : "v"(lo), "v"(hi)); return r; }
typedef float f32x2 __attribute__((ext_vector_type(2)));
template <class Epi, class Sched, bool ALIGN_EPI = false, bool SP2 = false>
__device__ __forceinline__ void gemm_phase(PG8_LAS unsigned char* lds, const Gemm g, const Sched& S, const Epi& E, const int tid) {
    const int wid = __builtin_amdgcn_readfirstlane(tid >> 6), lane = tid & 63, wr = wid >> 2, wc = wid & 3, fr = lane & 15, fq = lane >> 4;
    const int K = g.K, nt = K / BK;
    unsigned voffA[2], voffB[2];
#pragma unroll
    for (int i = 0; i < 2; ++i) { int R, C; stage_rc(tid * 16 + i * 8192, R, C); const int Rb = Epi::PERM ? ((R & ~31) + perm32(R & 31)) : R;
        voffA[i] = (unsigned)(R * g.lda + C) * 2u; voffB[i] = (unsigned)(Rb * K + C) * 2u; }
    const size_t kstep = (size_t)(BK * 2);
    const size_t hstep = (size_t)HALF * K * 2;
    const size_t tstep = 2 * hstep; const size_t hstepA = (size_t)HALF * g.lda * 2, tstepA = 2 * hstepA;
    const unsigned ldsw = (unsigned)wid * 1024u;
    const int aoff = lds_byte(wr * 64 + fr, fq * 8), boff = lds_byte(wc * 32 + fr, fq * 8);
#define PG8_SA(b, h) (((b) * 2 + (h)) * HTB)
#define PG8_SB(b, h) ((4 + (b) * 2 + (h)) * HTB)
#define PG8_STAGE(bufoff, gbase, voff) do { _Pragma("unroll") for (int _i = 0; _i < 2; ++_i) \
        __builtin_amdgcn_global_load_lds((const unsigned*)((const char*)(gbase) + (voff)[_i]), (PG8_LAS unsigned*)(lds + (bufoff) + ldsw + _i * 8192), 16, 0, 0); } while (0)
#define PG8_LDA(dst, b, h) do { _Pragma("unroll") for (int m = 0; m < 4; ++m) _Pragma("unroll") for (int k = 0; k < 2; ++k) dst[m][k] = *(const PG8_LAS bf16x8*)(lds + PG8_SA(b, h) + aoff + m * 2048 + k * 1024); } while (0)
#define PG8_LDB(dst, b, h) do { _Pragma("unroll") for (int n = 0; n < 2; ++n) _Pragma("unroll") for (int k = 0; k < 2; ++k) dst[n][k] = *(const PG8_LAS bf16x8*)(lds + PG8_SB(b, h) + boff + n * 2048 + k * 1024); } while (0)
#define PG8_MMA(ai, bj, At, Bt) do { __builtin_amdgcn_s_setprio(1); _Pragma("unroll") for (int m = 0; m < 4; ++m) _Pragma("unroll") for (int n = 0; n < 2; ++n) _Pragma("unroll") for (int k = 0; k < 2; ++k) \
        acc[ai][bj][m][n] = __builtin_amdgcn_mfma_f32_16x16x32_bf16(Bt[n][k], At[m][k], acc[ai][bj][m][n], 0, 0, 0); __builtin_amdgcn_s_setprio(0); } while (0)
#define PG8_WAIT_V(n) asm volatile("s_waitcnt vmcnt(" #n ")" ::: "memory")
#define PG8_WAIT_L(n) asm volatile("s_waitcnt lgkmcnt(" #n ")" ::: "memory")
#define PG8_BAR __builtin_amdgcn_s_barrier()
#define PG8_SCHED __builtin_amdgcn_sched_barrier(0)
    Unit cur, nxt; int ui = 0;
    if (!S.next(0, cur)) return;
    f32x4 acc[2][2][4][2];
#pragma unroll
    for (int a = 0; a < 2; ++a)
#pragma unroll
        for (int b = 0; b < 2; ++b)
#pragma unroll
            for (int m = 0; m < 4; ++m)
#pragma unroll
                for (int n = 0; n < 2; ++n) acc[a][b][m][n] = (f32x4){0.f, 0.f, 0.f, 0.f};
    bf16x8 At[4][2], B0[2][2], B1[2][2];
    const char* cA = (const char*)g.A + (size_t)cur.pm * tstepA; const char* cB = (const char*)g.Bt + (size_t)cur.pn * tstep;
    S.a_ready(cur);
    if constexpr (SP2) {
        PG8_STAGE(PG8_SB(0, 0), cB, voffB); PG8_STAGE(PG8_SB(0, 1), cB + hstep, voffB); PG8_STAGE(PG8_SA(0, 0), cA, voffA); PG8_STAGE(PG8_SA(0, 1), cA + hstepA, voffA);
        if (wr == 1) PG8_BAR;
        PG8_WAIT_V(2); PG8_BAR;
        PG8_STAGE(PG8_SB(1, 0), cB + kstep, voffB); PG8_STAGE(PG8_SA(1, 0), cA + kstep, voffA); PG8_STAGE(PG8_SB(1, 1), cB + hstep + kstep, voffB);
        PG8_WAIT_V(6); PG8_BAR;
    } else {
        PG8_STAGE(PG8_SB(0, 0), cB, voffB); PG8_STAGE(PG8_SA(0, 0), cA, voffA); PG8_STAGE(PG8_SB(0, 1), cB + hstep, voffB); PG8_STAGE(PG8_SA(0, 1), cA + hstepA, voffA);
        if (wr == 1) PG8_BAR;
        PG8_WAIT_V(4); PG8_BAR;
        PG8_STAGE(PG8_SB(1, 0), cB + kstep, voffB); PG8_STAGE(PG8_SA(1, 0), cA + kstep, voffA); PG8_STAGE(PG8_SB(1, 1), cB + hstep + kstep, voffB);
        PG8_WAIT_V(6); PG8_BAR;
    }
    for (;;) {
        const bool has_next = S.next(ui + 1, nxt);
        const char* nA = has_next ? (const char*)g.A + (size_t)nxt.pm * tstepA : cA; const char* nB = has_next ? (const char*)g.Bt + (size_t)nxt.pn * tstep : cB;
        for (int t = 0; t < nt; t += 2) {
            const bool last = (t == nt - 2);
            const char* a1 = cA + (size_t)(t + 1) * kstep;
            const char* a2 = last ? nA : cA + (size_t)(t + 2) * kstep; const char* b2 = last ? nB : cB + (size_t)(t + 2) * kstep;
            const char* a3 = a2 + kstep; const char* b3 = b2 + kstep;
            if (last && has_next) S.a_ready(nxt);
            if constexpr (SP2) {
            PG8_LDB(B0, 0, 0); PG8_LDB(B1, 0, 1); PG8_SCHED; PG8_LDA(At, 0, 0); PG8_STAGE(PG8_SA(1, 1), a1 + hstepA, voffA);
            PG8_WAIT_V(8); PG8_WAIT_L(0); PG8_BAR; PG8_MMA(0, 0, At, B0); PG8_MMA(0, 1, At, B1); PG8_BAR; PG8_SCHED;
            PG8_LDA(At, 0, 1); PG8_STAGE(PG8_SB(0, 0), b2, voffB); PG8_STAGE(PG8_SB(0, 1), b2 + hstep, voffB); PG8_STAGE(PG8_SA(0, 0), a2, voffA);
            PG8_WAIT_V(8); PG8_WAIT_L(0); PG8_BAR; PG8_MMA(1, 0, At, B0); PG8_MMA(1, 1, At, B1); PG8_BAR; PG8_SCHED;
            PG8_LDB(B0, 1, 0); PG8_LDB(B1, 1, 1); PG8_SCHED; PG8_LDA(At, 1, 0); PG8_STAGE(PG8_SA(0, 1), a2 + hstepA, voffA);
            PG8_WAIT_V(8); PG8_WAIT_L(0); PG8_BAR; PG8_MMA(0, 0, At, B0); PG8_MMA(0, 1, At, B1); PG8_BAR; PG8_SCHED;
            PG8_LDA(At, 1, 1); PG8_STAGE(PG8_SB(1, 0), b3, voffB); PG8_STAGE(PG8_SB(1, 1), b3 + hstep, voffB); PG8_STAGE(PG8_SA(1, 0), a3, voffA);
            PG8_WAIT_V(8); PG8_WAIT_L(0); PG8_BAR; PG8_MMA(1, 0, At, B0); PG8_MMA(1, 1, At, B1); PG8_BAR; PG8_SCHED;
            } else {
            PG8_LDB(B0, 0, 0); PG8_SCHED; PG8_LDA(At, 0, 0); PG8_STAGE(PG8_SA(1, 1), a1 + hstepA, voffA);
            PG8_WAIT_L(8); PG8_BAR; PG8_WAIT_L(0); PG8_MMA(0, 0, At, B0); PG8_BAR; PG8_SCHED;
            PG8_LDB(B1, 0, 1); PG8_STAGE(PG8_SB(0, 0), b2, voffB);
            PG8_BAR; PG8_WAIT_L(0); PG8_MMA(0, 1, At, B1); PG8_BAR;
            PG8_LDA(At, 0, 1); PG8_STAGE(PG8_SA(0, 0), a2, voffA);
            PG8_BAR; PG8_WAIT_L(0); PG8_MMA(1, 0, At, B0); PG8_BAR; PG8_SCHED;
            PG8_STAGE(PG8_SB(0, 1), b2 + hstep, voffB);
            PG8_WAIT_V(6); PG8_BAR; PG8_MMA(1, 1, At, B1); PG8_BAR;
            PG8_LDB(B0, 1, 0); PG8_SCHED; PG8_LDA(At, 1, 0); PG8_STAGE(PG8_SA(0, 1), a2 + hstepA, voffA);
            PG8_WAIT_L(8); PG8_BAR; PG8_WAIT_L(0); PG8_MMA(0, 0, At, B0); PG8_BAR; PG8_SCHED;
            PG8_LDB(B1, 1, 1); PG8_STAGE(PG8_SB(1, 0), b3, voffB);
            PG8_BAR; PG8_WAIT_L(0); PG8_MMA(0, 1, At, B1); PG8_BAR;
            PG8_LDA(At, 1, 1); PG8_STAGE(PG8_SA(1, 0), a3, voffA);
            PG8_BAR; PG8_WAIT_L(0); PG8_MMA(1, 0, At, B0); PG8_BAR; PG8_SCHED;
            PG8_STAGE(PG8_SB(1, 1), b3 + hstep, voffB);
            PG8_WAIT_V(6); PG8_BAR; PG8_MMA(1, 1, At, B1); PG8_BAR;
            }
        }
        if constexpr (ALIGN_EPI) { if (wr == 0) PG8_BAR; }
        if constexpr (!Epi::AFTER_DRAIN) { E(acc, cur, wr, wc, fr, fq); S.done(cur); }
        if (!has_next) break;
#pragma unroll
        for (int a = 0; a < 2; ++a)
#pragma unroll
            for (int b = 0; b < 2; ++b)
#pragma unroll
                for (int m = 0; m < 4; ++m)
#pragma unroll
                    for (int n = 0; n < 2; ++n) acc[a][b][m][n] = (f32x4){0.f, 0.f, 0.f, 0.f};
        cur = nxt; cA = nA; cB = nB; ++ui;
        if constexpr (ALIGN_EPI) { if (wr == 1) PG8_BAR; }
    }
    PG8_WAIT_V(0);
    if constexpr (!ALIGN_EPI) { if (wr == 0) PG8_BAR; }
    PG8_BAR;
    if constexpr (Epi::AFTER_DRAIN) { E.fused(acc, cur, wr, wc, fr, fq, lds, wid, lane); S.done(cur); }
#undef PG8_SA
#undef PG8_SB
#undef PG8_STAGE
#undef PG8_LDA
#undef PG8_LDB
#undef PG8_MMA
#undef PG8_WAIT_V
#undef PG8_WAIT_L
#undef PG8_BAR
#undef PG8_SCHED
}
}

#define LAS __attribute__((address_space(3)))
typedef unsigned short bf16;
typedef short bf16x8 __attribute__((ext_vector_type(8)));
typedef short v4i16_t __attribute__((ext_vector_type(4)));
typedef float f32x4 __attribute__((ext_vector_type(4)));
typedef float f32x2 __attribute__((ext_vector_type(2)));
typedef float f32x16 __attribute__((ext_vector_type(16)));
typedef unsigned u32x4 __attribute__((ext_vector_type(4)));
typedef unsigned u32x2 __attribute__((ext_vector_type(2)));

constexpr int T = 98304, TP = 32768, DM = 1024, FF = 2816, NIN = 3584, SEQ = 2048, NB = 48;
constexpr float EPS = 1e-6f, LOG2E = 1.4426950408889634f;
constexpr float C2 = 0.125f * LOG2E;
constexpr size_t MiB = 1u << 20;
constexpr size_t WS_STAT = 8 * MiB  , WS_ROT = 4 * MiB, WS_W = 16 * MiB, W_LAYER = 42 * MiB, WS_HB = 104 * MiB, WS_P = 296 * MiB, WS_END = 968 * MiB;
constexpr size_t WO_GU1 = 0, WO_D1 = 11534336, WO_IN = WO_D1 + 5767168, WO_OUT = WO_IN + 7340032, WO_GU2 = WO_OUT + 2097152, WO_D2 = WO_GU2 + 11534336;
static_assert(WO_D2 + 5767168 == W_LAYER, "weight map");
constexpr int LDS_BYTES = 147456;
constexpr int LDS_TAB = 131072, LDS_MISC = 139264, LDS_STATS = 131072, LDS_BARW = 143360;
constexpr size_t WS_BAR = 5 * MiB, WS_BAR_BYTES = 16384;
constexpr int NPHASE = 21;

typedef unsigned long long u64;
__device__ __forceinline__ float ss_scale(const u64* ss, int row) { return __builtin_amdgcn_rsqf((float)ss[row] * (1.f / 4294967296.f / 1024.f) + EPS); }
__device__ __forceinline__ u64 ss_fix(float q) { return (u64)(q * 4294967296.f); }
struct Args { const float* in[21]; float* out; unsigned char* ws; int lo, hi, dry, pad; };

#define LDS_WAIT() asm volatile("s_waitcnt lgkmcnt(0)" ::: "memory")

__device__ __forceinline__ unsigned pkbf(float lo, float hi) { typedef __bf16 bf2_t __attribute__((ext_vector_type(2))); f32x2 v = {lo, hi}; bf2_t b = __builtin_convertvector(v, bf2_t); return __builtin_bit_cast(unsigned, b); }
__device__ __forceinline__ float bflo(unsigned u) { return __builtin_bit_cast(float, u << 16); }
__device__ __forceinline__ float bfhi(unsigned u) { return __builtin_bit_cast(float, u & 0xffff0000u); }
__device__ __forceinline__ float wave_sum(float v) {
#pragma unroll
    for (int o = 1; o < 64; o <<= 1) v += __shfl_xor(v, o);
    return v;
}
__device__ __forceinline__ float wave_max(float v) {
#pragma unroll
    for (int o = 1; o < 64; o <<= 1) v = fmaxf(v, __shfl_xor(v, o));
    return v;
}
__device__ __forceinline__ float silu_f(float g) { return g * __builtin_amdgcn_rcpf(1.f + __builtin_amdgcn_exp2f(-g * LOG2E)); }
__device__ __forceinline__ int crow(int r, int hi) { return (r & 3) + 8 * (r >> 2) + 4 * hi; }
__device__ __forceinline__ unsigned offb(unsigned row, unsigned ch) { return 256u * row + 16u * (ch ^ (((row & 3u) << 2) | ((row >> 2) & 3u))); }
__device__ __forceinline__ unsigned tr_base_perm(int c, int tt, int lane) {
    const unsigned hi = lane >> 5, g1 = (lane >> 4) & 1, q4 = (lane & 15) >> 2, p4 = lane & 3, lowc = 2 * g1 + (p4 >> 1);
    return 1024u * hi + 256u * q4 + 8u * (p4 & 1) + 64u * ((unsigned)c ^ q4) + 16u * ((lowc ^ hi) ^ (2u * tt));
}
__device__ __forceinline__ unsigned tr_base_nat(int c, int tt, int lane) {
    const unsigned hi = lane >> 5, g1 = (lane >> 4) & 1, q4 = (lane & 15) >> 2, p4 = lane & 3, lowc = 2 * g1 + (p4 >> 1);
    return 2048u * hi + 256u * q4 + 8u * (p4 & 1) + 64u * ((unsigned)c ^ q4) + 16u * ((lowc ^ (2u * hi)) ^ (unsigned)tt);
}
__device__ __forceinline__ unsigned row_base(int cK, int lane) {
    const unsigned r32 = lane & 31, hi = lane >> 5, xk = ((r32 & 3u) << 2) | ((r32 >> 2) & 3u);
    return 256u * r32 + 16u * (((unsigned)cK + hi) ^ xk);
}
__device__ __forceinline__ bf16x8 tr_pair(const LAS unsigned char* p0, const LAS unsigned char* p1) {
    const v4i16_t lo = __builtin_amdgcn_ds_read_tr16_b64_v4i16((LAS v4i16_t*)p0);
    const v4i16_t hi = __builtin_amdgcn_ds_read_tr16_b64_v4i16((LAS v4i16_t*)p1);
    return (bf16x8){lo[0], lo[1], lo[2], lo[3], hi[0], hi[1], hi[2], hi[3]};
}
__device__ __forceinline__ bf16x8 pack8(const f32x16& S, int s) {
    u32x4 w; w.x = pkbf(S[8 * s + 0], S[8 * s + 1]); w.y = pkbf(S[8 * s + 2], S[8 * s + 3]); w.z = pkbf(S[8 * s + 4], S[8 * s + 5]); w.w = pkbf(S[8 * s + 6], S[8 * s + 7]);
    return __builtin_bit_cast(bf16x8, w);
}
__device__ __forceinline__ int rel_bucket(int rel) {
    const int n = rel < 0 ? -rel : rel; int b;
    if (n < 8) b = n; else if (n < 12) b = 8; else if (n < 16) b = 9; else if (n < 23) b = 10; else if (n < 32) b = 11; else if (n < 46) b = 12; else if (n < 64) b = 13; else if (n < 91) b = 14; else b = 15;
    return b + (rel > 0 ? 16 : 0);
}

template <bool NN> struct EpiSwiGLU {
    static constexpr bool PERM = true, AFTER_DRAIN = false;
    bf16* O; const u64* ss; const u64* ssw;
    __device__ __forceinline__ void operator()(const f32x4 (&acc)[2][2][4][2], const pg8::Unit& u, int wr, int wc, int fr, int fq) const {
        const int row0 = u.pm * 256 + wr * 64 + fr, col0 = u.pn * 128 + wc * 32 + 8 * fq;
#pragma unroll
        for (int ai = 0; ai < 2; ++ai)
#pragma unroll
            for (int m = 0; m < 4; ++m) {
                const int row = row0 + ai * 128 + m * 16;
                float s = ss_scale(ss, row);
                if constexpr (NN) s *= __builtin_amdgcn_rsqf(s * s * (float)ssw[row] * (1.f / 4294967296.f / 1024.f) + EPS);
                float a[8];
#pragma unroll
                for (int n = 0; n < 2; ++n)
#pragma unroll
                    for (int i = 0; i < 4; ++i) { const float g = acc[ai][0][m][n][i] * s, uu = acc[ai][1][m][n][i] * s; a[4 * n + i] = silu_f(g) * uu; }
                u32x4 w; w.x = pkbf(a[0], a[1]); w.y = pkbf(a[2], a[3]); w.z = pkbf(a[4], a[5]); w.w = pkbf(a[6], a[7]);
                *(u32x4*)(O + (size_t)row * FF + col0) = w;
            }
    }
};
template <int MODE, bool WF32> struct EpiRes {
    static constexpr bool PERM = true, AFTER_DRAIN = false;
    float* out; bf16* hb; u64* ssn; int dry; const float* gf; const u64* rss; u64* ssw;
    __device__ __forceinline__ void operator()(const f32x4 (&acc)[2][2][4][2], const pg8::Unit& u, int wr, int wc, int fr, int fq) const {
        if (dry) return;
        const int row0 = u.pm * 256 + wr * 64 + fr, col0 = u.pn * 256 + wc * 32 + 8 * fq;
        f32x4 g0[2], g1[2];
        if constexpr (MODE != 0) {
#pragma unroll
            for (int bj = 0; bj < 2; ++bj) { g0[bj] = *(const f32x4*)(gf + col0 + bj * 128); g1[bj] = *(const f32x4*)(gf + col0 + bj * 128 + 4); if constexpr (MODE == 1) { g0[bj] = g0[bj] * g0[bj]; g1[bj] = g1[bj] * g1[bj]; } }
        }
#pragma unroll
        for (int ai = 0; ai < 2; ++ai)
#pragma unroll
            for (int m = 0; m < 4; ++m) {
                const int row = row0 + ai * 128 + m * 16;
                float q = 0.f, qw = 0.f, sh = 1.f;
                if constexpr (MODE == 2) sh = ss_scale(rss, row);
#pragma unroll
                for (int bj = 0; bj < 2; ++bj) {
                    const int c = col0 + bj * 128;
                    const u32x4 rb = *(const u32x4*)(hb + (size_t)row * DM + c);
                    f32x4 r0 = {bflo(rb.x), bfhi(rb.x), bflo(rb.y), bfhi(rb.y)}, r1 = {bflo(rb.z), bfhi(rb.z), bflo(rb.w), bfhi(rb.w)};
                    if constexpr (MODE == 2) { r0 = r0 * sh * g0[bj]; r1 = r1 * sh * g1[bj]; }
                    const f32x4 v0 = r0 + acc[ai][bj][m][0], v1 = r1 + acc[ai][bj][m][1];
                    if constexpr (WF32) { *(f32x4*)(out + (size_t)row * DM + c) = v0; *(f32x4*)(out + (size_t)row * DM + c + 4) = v1; }
                    u32x4 w; w.x = pkbf(v0[0], v0[1]); w.y = pkbf(v0[2], v0[3]); w.z = pkbf(v1[0], v1[1]); w.w = pkbf(v1[2], v1[3]);
                    *(u32x4*)(hb + (size_t)row * DM + c) = w;
                    const f32x4 s0 = v0 * v0, s1 = v1 * v1;
                    q += (s0[0] + s0[1]) + (s0[2] + s0[3]) + (s1[0] + s1[1]) + (s1[2] + s1[3]);
                    if constexpr (MODE == 1) { const f32x4 t0 = s0 * g0[bj], t1 = s1 * g1[bj]; qw += (t0[0] + t0[1]) + (t0[2] + t0[3]) + (t1[0] + t1[1]) + (t1[2] + t1[3]); }
                }
                q += __shfl_xor(q, 16); q += __shfl_xor(q, 32);
                if constexpr (MODE == 1) { qw += __shfl_xor(qw, 16); qw += __shfl_xor(qw, 32); }
                if (fq == 0) {
                    __hip_atomic_fetch_add(ssn + row, ss_fix(q), __ATOMIC_RELAXED, __HIP_MEMORY_SCOPE_AGENT);
                    if constexpr (MODE == 1) __hip_atomic_fetch_add(ssw + row, ss_fix(qw), __ATOMIC_RELAXED, __HIP_MEMORY_SCOPE_AGENT);
                }
            }
    }
};
struct EpiWin {
    static constexpr bool PERM = true, AFTER_DRAIN = false;
    bf16* P; const u64* ss; const f32x2* rot; const float* qg; const float* kg;
    __device__ __forceinline__ void operator()(const f32x4 (&acc)[2][2][4][2], const pg8::Unit& u, int wr, int wc, int fr, int fq) const {
        const int type = u.pn >> 1;
        const int row0 = u.pm * 256 + wr * 64 + fr, cbase = u.pn * 256;
        if (type <= 1) {
            const int hh = wc >> 1, j0 = 32 * (wc & 1) + 8 * fq;
#pragma unroll
            for (int ai = 0; ai < 2; ++ai)
#pragma unroll
                for (int m = 0; m < 4; ++m) {
                    const int row = row0 + ai * 128 + m * 16;
                    const float s = ss_scale(ss, row);
                    const f32x4* rp = (const f32x4*)(rot + (size_t)(row & (SEQ - 1)) * 64 + j0);
                    float o1[8], o2[8];
#pragma unroll
                    for (int n = 0; n < 2; ++n) {
                        const f32x4 cs0 = rp[2 * n], cs1 = rp[2 * n + 1];
                        const float cc[4] = {cs0[0], cs0[2], cs1[0], cs1[2]}, sn[4] = {cs0[1], cs0[3], cs1[1], cs1[3]};
#pragma unroll
                        for (int i = 0; i < 4; ++i) { const float x1 = acc[ai][0][m][n][i] * s, x2 = acc[ai][1][m][n][i] * s; o1[4 * n + i] = x1 * cc[i] - x2 * sn[i]; o2[4 * n + i] = x1 * sn[i] + x2 * cc[i]; }
                    }
                    bf16* op = P + (size_t)row * NIN + cbase + hh * 128 + j0;
                    u32x4 w; w.x = pkbf(o1[0], o1[1]); w.y = pkbf(o1[2], o1[3]); w.z = pkbf(o1[4], o1[5]); w.w = pkbf(o1[6], o1[7]); *(u32x4*)op = w;
                    w.x = pkbf(o2[0], o2[1]); w.y = pkbf(o2[2], o2[3]); w.z = pkbf(o2[4], o2[5]); w.w = pkbf(o2[6], o2[7]); *(u32x4*)(op + 64) = w;
                }
        } else if (type == 4 || type == 5) {
            const int hh = wc >> 1, t = wc & 1; const float* gp = (type == 4 ? qg : kg) + t * 64 + 8 * fq; const float mul = (type == 4) ? C2 : 1.f;
            float gv[2][8];
#pragma unroll
            for (int bj = 0; bj < 2; ++bj)
#pragma unroll
                for (int i = 0; i < 8; ++i) gv[bj][i] = gp[bj * 32 + i] * mul;
#pragma unroll
            for (int ai = 0; ai < 2; ++ai)
#pragma unroll
                for (int m = 0; m < 4; ++m) {
                    const int row = row0 + ai * 128 + m * 16;
                    const float s = ss_scale(ss, row);
                    float v[2][8]; float q = 0.f;
#pragma unroll
                    for (int bj = 0; bj < 2; ++bj)
#pragma unroll
                        for (int n = 0; n < 2; ++n)
#pragma unroll
                            for (int i = 0; i < 4; ++i) { const float x = acc[ai][bj][m][n][i] * s; v[bj][4 * n + i] = x; q += x * x; }
                    q += __shfl_xor(q, 16); q += __shfl_xor(q, 32);
                    const float rs = __builtin_amdgcn_rsqf(q * (1.f / 64.f) + EPS);
                    bf16* op = P + (size_t)row * NIN + cbase + hh * 128 + t * 64 + 8 * fq;
#pragma unroll
                    for (int bj = 0; bj < 2; ++bj) {
                        u32x4 w; w.x = pkbf(v[bj][0] * rs * gv[bj][0], v[bj][1] * rs * gv[bj][1]); w.y = pkbf(v[bj][2] * rs * gv[bj][2], v[bj][3] * rs * gv[bj][3]);
                        w.z = pkbf(v[bj][4] * rs * gv[bj][4], v[bj][5] * rs * gv[bj][5]); w.w = pkbf(v[bj][6] * rs * gv[bj][6], v[bj][7] * rs * gv[bj][7]);
                        *(u32x4*)(op + bj * 32) = w;
                    }
                }
        } else {
            const bool act = (type == 3);
#pragma unroll
            for (int ai = 0; ai < 2; ++ai)
#pragma unroll
                for (int m = 0; m < 4; ++m) {
                    const int row = row0 + ai * 128 + m * 16;
                    const float s = ss_scale(ss, row);
                    bf16* op = P + (size_t)row * NIN + cbase + wc * 32 + 8 * fq;
#pragma unroll
                    for (int bj = 0; bj < 2; ++bj) {
                        float v[8];
#pragma unroll
                        for (int n = 0; n < 2; ++n)
#pragma unroll
                            for (int i = 0; i < 4; ++i) { const float x = acc[ai][bj][m][n][i] * s; v[4 * n + i] = act ? silu_f(x) : x; }
                        u32x4 w; w.x = pkbf(v[0], v[1]); w.y = pkbf(v[2], v[3]); w.z = pkbf(v[4], v[5]); w.w = pkbf(v[6], v[7]);
                        *(u32x4*)(op + bj * 128) = w;
                    }
                }
        }
    }
};

__device__ __forceinline__ void tr_item(const float* W, int ldw, int K, int k0, int srccol0, bf16* WT, int dstrow0, const float* gain, float scale, LAS float* scr, int lane, const float* gain2 = nullptr) {
#pragma unroll
    for (int i = 0; i < 32; ++i) { const int kk = 2 * i + (lane >> 5); float gsc = gain ? gain[k0 + kk] * scale : scale; if (gain2) gsc *= gain2[k0 + kk]; scr[kk * 33 + (lane & 31)] = W[(size_t)(k0 + kk) * ldw + srccol0 + (lane & 31)] * gsc; }
    LDS_WAIT();
    const int c = lane & 7;
#pragma unroll
    for (int j = 0; j < 4; ++j) { const int n = (lane >> 3) + 8 * j; const LAS float* s = scr + (8 * c) * 33 + n;
        u32x4 o; o.x = pkbf(s[0 * 33], s[1 * 33]); o.y = pkbf(s[2 * 33], s[3 * 33]); o.z = pkbf(s[4 * 33], s[5 * 33]); o.w = pkbf(s[6 * 33], s[7 * 33]);
        *(u32x4*)(WT + (size_t)(dstrow0 + n) * K + k0 + 8 * c) = o; }
    LDS_WAIT();
}
__device__ __forceinline__ void phase_prep(const Args& a, unsigned char* ws, LAS unsigned char* lds, int vcu, int G, int tid, int wid, int lane) {
    LAS float* scr = (LAS float*)(lds + wid * 16384);
    const int gw = vcu * 8 + wid, NGW = G * 8;
    constexpr int I_GU = 16 * 176, I_D = 44 * 32, I_IN = 16 * 112, I_OUT = 16 * 32, I_L = 2 * I_GU + 2 * I_D + I_IN + I_OUT;
    for (int it = gw; it < 2 * I_L; it += NGW) {
        const int l = it / I_L; int r = it % I_L;
        unsigned char* wl = ws + WS_W + (size_t)l * W_LAYER;
        if (r < I_GU || (r >= I_GU + I_D + I_IN + I_OUT && r < 2 * I_GU + I_D + I_IN + I_OUT)) {
            const bool second = r >= I_GU; if (second) r -= I_GU + I_D + I_IN + I_OUT;
            const int kb = r / 176, nb = r % 176, n0 = nb * 32, pn = n0 >> 8, half = (n0 >> 7) & 1, j0 = n0 & 127;
            const float* src = a.in[second ? (half ? 18 : 17) : (half ? 4 : 3)] + (size_t)l * DM * FF;
            tr_item(src, FF, DM, kb * 64, pn * 128 + j0, (bf16*)(wl + (second ? WO_GU2 : WO_GU1)), n0, a.in[second ? 16 : 2] + l * DM, 1.f, scr, lane, (!second && l > 0) ? a.in[20] + (l - 1) * DM : nullptr);
            continue;
        }
        r -= I_GU;
        if (r < I_D) { const int kb = r / 32, nb = r % 32; tr_item(a.in[5] + (size_t)l * FF * DM, DM, FF, kb * 64, nb * 32, (bf16*)(wl + WO_D1), nb * 32, nullptr, 0.5f, scr, lane); continue; }
        r -= I_D;
        if (r < I_IN) {
            const int kb = r / 112, nb = r % 112, n0 = nb * 32, pn = n0 >> 8, w = n0 & 255, bj = w >> 7, q0 = w & 127, type = pn >> 1;
            int src;
            if (type <= 1) src = pn * 256 + (q0 >> 6) * 128 + bj * 64 + (q0 & 63);
            else if (type == 4 || type == 5) { const int wc = q0 >> 5; src = pn * 256 + (wc >> 1) * 128 + (wc & 1) * 64 + bj * 32; }
            else src = n0;
            tr_item(a.in[7] + (size_t)l * DM * NIN, NIN, DM, kb * 64, src, (bf16*)(wl + WO_IN), n0, a.in[6] + l * DM, type == 1 ? 0.08838834764831845f : 1.f, scr, lane);
            continue;
        }
        r -= I_IN;
        if (r < I_OUT) { const int kb = r / 32, nb = r % 32; tr_item(a.in[15] + (size_t)l * DM * DM, DM, DM, kb * 64, nb * 32, (bf16*)(wl + WO_OUT), nb * 32, nullptr, 1.f, scr, lane); continue; }
        r -= I_OUT + I_GU;
        { const int kb = r / 32, nb = r % 32; tr_item(a.in[19] + (size_t)l * FF * DM, DM, FF, kb * 64, nb * 32, (bf16*)(wl + WO_D2), nb * 32, nullptr, 0.5f, scr, lane); }
    }
    u64* stat = (u64*)(ws + WS_STAT); bf16* hb = (bf16*)(ws + WS_HB);
    for (int row0 = gw; row0 < T; row0 += 4 * NGW) {
        f32x4 v[4][4]; float sq[4];
#pragma unroll
        for (int k = 0; k < 4; ++k) {
            const int row = row0 + k * NGW;
            if (row < T) {
                const float* xr = (row < TP) ? a.in[0] + (size_t)row * DM : a.in[1] + (size_t)(row - TP) * DM;
#pragma unroll
                for (int j = 0; j < 4; ++j) v[k][j] = ((const f32x4*)xr)[lane + 64 * j];
            }
        }
#pragma unroll
        for (int k = 0; k < 4; ++k) {
            const int row = row0 + k * NGW;
            if (row < T) {
                float s = 0.f;
#pragma unroll
                for (int j = 0; j < 4; ++j) s += (v[k][j][0] * v[k][j][0] + v[k][j][1] * v[k][j][1]) + (v[k][j][2] * v[k][j][2] + v[k][j][3] * v[k][j][3]);
                sq[k] = wave_sum(s);
                if (lane == 0) stat[row] = ss_fix(sq[k]);
#pragma unroll
                for (int j = 0; j < 4; ++j) { u32x2 w; w.x = pkbf(v[k][j][0], v[k][j][1]); w.y = pkbf(v[k][j][2], v[k][j][3]); *(u32x2*)(hb + (size_t)row * DM + 4 * (lane + 64 * j)) = w; }
            }
        }
    }
    const int gt = vcu * 512 + tid, NT = G * 512;
    for (int i = gt; i < T; i += NT) { stat[1 * T + i] = 0; stat[2 * T + i] = 0; stat[3 * T + i] = 0; stat[4 * T + i] = 0; stat[5 * T + i] = 0; stat[6 * T + i] = 0; stat[7 * T + i] = 0; }
    f32x2* rot = (f32x2*)(ws + WS_ROT);
    for (int i = gt; i < SEQ * 64; i += NT) {
        const int pos = i >> 6, j = i & 63;
        const float inv = exp2f((float)(-j) * 0.20762050593046015f);
        const float ang = (float)pos * inv;
        const float fr = fmaf(ang, 0.15915494309189535f, -rintf(ang * 0.15915494309189535f));
        rot[i] = (f32x2){__builtin_amdgcn_cosf(fr), __builtin_amdgcn_sinf(fr)};
    }
}

__device__ __forceinline__ void phase_fnorm(const Args& a, unsigned char* ws, float* outp, int l, int vcu, int G, int wid, int lane) {
    const int gw = vcu * 8 + wid, NGW = G * 8;
    u64* stat = (u64*)(ws + WS_STAT); bf16* hb = (bf16*)(ws + WS_HB);
    const f32x4* gp = (const f32x4*)(a.in[20] + l * DM);
    f32x4 g[4];
#pragma unroll
    for (int j = 0; j < 4; ++j) g[j] = gp[lane + 64 * j];
    for (int row0 = gw; row0 < T; row0 += 4 * NGW) {
        f32x4 v[4][4]; float sc[4];
#pragma unroll
        for (int k = 0; k < 4; ++k) {
            const int row = row0 + k * NGW;
            if (row < T) {
                const bf16* hr = hb + (size_t)row * DM;
#pragma unroll
                for (int j = 0; j < 4; ++j) { const u32x2 w = *(const u32x2*)(hr + 4 * (lane + 64 * j)); v[k][j] = (f32x4){bflo(w.x), bfhi(w.x), bflo(w.y), bfhi(w.y)}; }
                sc[k] = ss_scale(stat + (size_t)(l * 4 + 3) * T, row);
            }
        }
#pragma unroll
        for (int k = 0; k < 4; ++k) {
            const int row = row0 + k * NGW;
            if (row < T) {
                float* hr = outp + (size_t)row * DM; float q = 0.f;
#pragma unroll
                for (int j = 0; j < 4; ++j) {
                    const f32x4 x = v[k][j] * sc[k] * g[j];
                    ((f32x4*)hr)[lane + 64 * j] = x; q += (x[0] * x[0] + x[1] * x[1]) + (x[2] * x[2] + x[3] * x[3]);
                    if (l == 0) { u32x2 w; w.x = pkbf(x[0], x[1]); w.y = pkbf(x[2], x[3]); *(u32x2*)(hb + (size_t)row * DM + 4 * (lane + 64 * j)) = w; }
                }
                if (l == 0) { q = wave_sum(q); if (lane == 0) stat[4 * T + row] = ss_fix(q); }
            }
        }
    }
}

__device__ __forceinline__ void ret_gammas(const Args& a, int l, int h, float& lgf2, float& lgb2) {
    const float xf = a.in[8][(l * 2 + 0) * 4 + h], xb = a.in[8][(l * 2 + 1) * 4 + h];
    lgf2 = -log1pf(expf(-xf)) * LOG2E; lgb2 = -log1pf(expf(-xb)) * LOG2E;
}
__device__ __forceinline__ void r1_unit(const Args& a, unsigned char* ws, bf16* STB, LAS unsigned char* lds, int l, int unit, int tid, int wid, int lane) {
    asm volatile("" : "+v"(lane), "+v"(tid));
    const int n = unit & 15, h = (unit >> 4) & 3, b = unit >> 6;
    float lgf2, lgb2; ret_gammas(a, l, h, lgf2, lgb2);
    const bf16* P = (const bf16*)(ws + WS_P);
    const bf16* kp = P + (size_t)(b * SEQ + n * 128) * NIN + 512 + h * 128;
    LAS unsigned char* KF = lds, * KB = lds + 32768, * VT = lds + 65536;
#pragma unroll
    for (int i = 0; i < 4; ++i) {
        const int c = tid + 512 * i, row = c >> 4, ch = c & 15;
        const u32x4 kv = *(const u32x4*)(kp + (size_t)row * NIN + ch * 8), vv = *(const u32x4*)(kp + 512 + (size_t)row * NIN + ch * 8);
        const float zf = __builtin_amdgcn_exp2f((float)(127 - row) * lgf2), zb = __builtin_amdgcn_exp2f((float)row * lgb2);
        u32x4 wf, wb;
#pragma unroll
        for (int e = 0; e < 4; ++e) { const float x0 = bflo(kv[e]), x1 = bfhi(kv[e]); wf[e] = pkbf(x0 * zf, x1 * zf); wb[e] = pkbf(x0 * zb, x1 * zb); }
        const unsigned o = offb(row, ch);
        *(LAS u32x4*)(KF + o) = wf; *(LAS u32x4*)(KB + o) = wb; *(LAS u32x4*)(VT + o) = vv;
    }
    __syncthreads();
    const int r32 = lane & 31, hi = lane >> 5, g1 = (lane >> 4) & 1, q4 = (lane & 15) >> 2, p4 = lane & 3;
    const int dir = wid >> 2, db = wid & 3;
    const LAS unsigned char* KS = dir ? KB : KF;
    f32x16 acc[4];
#pragma unroll
    for (int eb = 0; eb < 4; ++eb)
#pragma unroll
        for (int r = 0; r < 16; ++r) acc[eb][r] = 0.f;
    unsigned vbn[4][2];
#pragma unroll
    for (int c = 0; c < 4; ++c) { vbn[c][0] = tr_base_nat(c, 0, lane); vbn[c][1] = tr_base_nat(c, 1, lane); }
    const unsigned kb0 = tr_base_nat(db, 0, lane), kb1 = tr_base_nat(db, 1, lane);
#pragma unroll
    for (int ks = 0; ks < 8; ++ks) {
        const bf16x8 bfr = tr_pair(KS + kb0 + 256 * (16 * ks), KS + kb1 + 256 * (16 * ks + 4));
#pragma unroll
        for (int eb = 0; eb < 4; ++eb) { const bf16x8 afr = tr_pair(VT + vbn[eb][0] + 256 * (16 * ks), VT + vbn[eb][1] + 256 * (16 * ks + 4)); acc[eb] = __builtin_amdgcn_mfma_f32_32x32x16_bf16(afr, bfr, acc[eb], 0, 0, 0); }
    }
    bf16* st = STB + ((size_t)(((b * 4 + h) * 16 + n) * 2 + dir)) * 16384 + (size_t)(32 * db + r32) * 128;
#pragma unroll
    for (int eb = 0; eb < 4; ++eb)
#pragma unroll
        for (int pr = 0; pr < 2; ++pr) {
            const unsigned ax = pkbf(acc[eb][8 * pr], acc[eb][8 * pr + 1]), ay = pkbf(acc[eb][8 * pr + 2], acc[eb][8 * pr + 3]), bx = pkbf(acc[eb][8 * pr + 4], acc[eb][8 * pr + 5]), by = pkbf(acc[eb][8 * pr + 6], acc[eb][8 * pr + 7]);
            const auto sx = __builtin_amdgcn_permlane32_swap(ax, bx, false, false), sy = __builtin_amdgcn_permlane32_swap(ay, by, false, false);
            u32x4 w; w.x = sx[0]; w.y = sy[0]; w.z = sx[1]; w.w = sy[1];
            *(u32x4*)(st + 32 * eb + 16 * pr + 8 * hi) = w; }
    __syncthreads();
}
__device__ __forceinline__ void phase_scan(const Args& a, unsigned char* ws, bf16* STB, int l, int vcu, int G, int tid, int z) {
    bf16* ST = STB;
    const int gt = vcu * 512 + tid, NT = G * 512;
    for (int it = gt; it < 192 * 2 * 2048; it += NT) {
        const int grp = it & 2047, dir = (it >> 11) & 1, bh = it >> 12, h = bh & 3;
        float lgf2, lgb2; ret_gammas(a, l, h, lgf2, lgb2);
        const float g = __builtin_amdgcn_exp2f(128.f * (dir ? lgb2 : lgf2));
        bf16* base = ST + ((size_t)(bh * 16) * 2 + dir) * 16384 + grp * 8;
        u32x4 kv[16];
        const size_t cst = (size_t)(32768 + z);
#pragma unroll
        for (int n = 0; n < 16; ++n) kv[n] = *(const u32x4*)(base + (size_t)n * cst);
        float c[8];
#pragma unroll
        for (int e = 0; e < 8; ++e) c[e] = 0.f;
#pragma unroll
        for (int i = 0; i < 16; ++i) {
            const int n = dir ? 15 - i : i;
            u32x4 w; w.x = pkbf(c[0], c[1]); w.y = pkbf(c[2], c[3]); w.z = pkbf(c[4], c[5]); w.w = pkbf(c[6], c[7]);
            *(u32x4*)(base + (size_t)n * cst) = w;
#pragma unroll
            for (int e = 0; e < 4; ++e) { c[2 * e] = bflo(kv[n][e]) + g * c[2 * e]; c[2 * e + 1] = bfhi(kv[n][e]) + g * c[2 * e + 1]; }
        }
    }
}
__device__ __forceinline__ void r2_unit(const Args& a, unsigned char* ws, bf16* STB, LAS unsigned char* lds, int l, int unit, int tid, int wid, int lane, int dry) {
    asm volatile("" : "+v"(lane), "+v"(tid));
    const int n = unit & 15, h = (unit >> 4) & 3, b = unit >> 6;
    float lgf2, lgb2; ret_gammas(a, l, h, lgf2, lgb2);
    bf16* P = (bf16*)(ws + WS_P);
    const bf16* kp = P + (size_t)(b * SEQ + n * 128) * NIN + 512 + h * 128;
    const bf16* sp = STB + ((size_t)((b * 4 + h) * 16 + n) * 2) * 16384;
    LAS unsigned char* KT = lds, * VT = lds + 32768, * SF = lds + 65536, * SB = lds + 98304;
#pragma unroll
    for (int i = 0; i < 4; ++i) {
        const int c = tid + 512 * i, row = c >> 4, ch = c & 15; const unsigned o = offb(row, ch);
        const u32x4 kv = *(const u32x4*)(kp + (size_t)row * NIN + ch * 8), vv = *(const u32x4*)(kp + 512 + (size_t)row * NIN + ch * 8);
        const u32x4 sf = *(const u32x4*)(sp + row * 128 + ch * 8), sb = *(const u32x4*)(sp + 16384 + row * 128 + ch * 8);
        *(LAS u32x4*)(KT + o) = kv; *(LAS u32x4*)(VT + o) = vv; *(LAS u32x4*)(SF + o) = sf; *(LAS u32x4*)(SB + o) = sb;
    }
    const int r32 = lane & 31, hi = lane >> 5, g1 = (lane >> 4) & 1, q4 = (lane & 15) >> 2, p4 = lane & 3;
    const int cb = wid & 3, eh = wid >> 2;
    const int cl = 32 * cb + r32;
    const size_t tok = (size_t)b * SEQ + n * 128 + cl;
    bf16x8 qf[8];
#pragma unroll
    for (int kd = 0; kd < 8; ++kd) qf[kd] = *(const bf16x8*)(P + tok * NIN + h * 128 + 16 * kd + 8 * hi);
    __syncthreads();
    f32x16 O[2], XF[2], XB[2];
#pragma unroll
    for (int e = 0; e < 2; ++e)
#pragma unroll
        for (int r = 0; r < 16; ++r) { O[e][r] = 0.f; XF[e][r] = 0.f; XB[e][r] = 0.f; }
    float ff[16], fb[16];
#pragma unroll
    for (int r = 0; r < 16; ++r) { ff[r] = __builtin_amdgcn_exp2f((float)(31 - crow(r, hi)) * lgf2); fb[r] = __builtin_amdgcn_exp2f((float)crow(r, hi) * lgb2); }
    unsigned vp[2][2], sn[2][2], kb[8];
#pragma unroll
    for (int e = 0; e < 2; ++e)
#pragma unroll
        for (int tt = 0; tt < 2; ++tt) { vp[e][tt] = tr_base_perm(2 * eh + e, tt, lane); sn[e][tt] = tr_base_nat(2 * eh + e, tt, lane); }
#pragma unroll
    for (int kd = 0; kd < 8; ++kd) kb[kd] = row_base(2 * kd, lane);
#pragma unroll
    for (int mb = 0; mb < 4; ++mb) {
        f32x16 S;
#pragma unroll
        for (int r = 0; r < 16; ++r) S[r] = 0.f;
#pragma unroll
        for (int kd = 0; kd < 8; ++kd) { const bf16x8 kf = *(const LAS bf16x8*)(KT + kb[kd] + 8192 * mb); S = __builtin_amdgcn_mfma_f32_32x32x16_bf16(kf, qf[kd], S, 0, 0, 0); }
        if (mb < cb) { const float fa = __builtin_amdgcn_exp2f((float)(cl - 32 * mb - 31) * lgf2);
#pragma unroll
            for (int r = 0; r < 16; ++r) S[r] *= fa * ff[r];
        } else if (mb > cb) { const float fa = __builtin_amdgcn_exp2f((float)(32 * mb - cl) * lgb2);
#pragma unroll
            for (int r = 0; r < 16; ++r) S[r] *= fa * fb[r];
        } else {
#pragma unroll
            for (int r = 0; r < 16; ++r) { const int rel = r32 - crow(r, hi); const float d = (rel >= 0) ? (float)rel * lgf2 : (float)(-rel) * lgb2; S[r] *= __builtin_amdgcn_exp2f(d); }
        }
#pragma unroll
        for (int s = 0; s < 2; ++s) {
            const bf16x8 pk = pack8(S, s);
#pragma unroll
            for (int e = 0; e < 2; ++e) { const bf16x8 vf = tr_pair(VT + vp[e][0] + 256 * (32 * mb + 16 * s), VT + vp[e][1] + 256 * (32 * mb + 16 * s + 8)); O[e] = __builtin_amdgcn_mfma_f32_32x32x16_bf16(vf, pk, O[e], 0, 0, 0); }
        }
    }
#pragma unroll
    for (int kd = 0; kd < 8; ++kd) {
#pragma unroll
        for (int e = 0; e < 2; ++e) {
            const bf16x8 ff = tr_pair(SF + sn[e][0] + 256 * (16 * kd), SF + sn[e][1] + 256 * (16 * kd + 4)); XF[e] = __builtin_amdgcn_mfma_f32_32x32x16_bf16(ff, qf[kd], XF[e], 0, 0, 0);
            const bf16x8 fb = tr_pair(SB + sn[e][0] + 256 * (16 * kd), SB + sn[e][1] + 256 * (16 * kd + 4)); XB[e] = __builtin_amdgcn_mfma_f32_32x32x16_bf16(fb, qf[kd], XB[e], 0, 0, 0);
        }
    }
    const float xf = __builtin_amdgcn_exp2f((float)(cl + 1) * lgf2), xb = __builtin_amdgcn_exp2f((float)(128 - cl) * lgb2);
    float s1 = 0.f, s2 = 0.f;
#pragma unroll
    for (int e = 0; e < 2; ++e)
#pragma unroll
        for (int r = 0; r < 16; ++r) { const float o = O[e][r] + xf * XF[e][r] + xb * XB[e][r]; O[e][r] = o; s1 += o; s2 += o * o; }
    s1 += __shfl_xor(s1, 32); s2 += __shfl_xor(s2, 32);
    LAS f32x2* stt = (LAS f32x2*)(lds + LDS_STATS);
    if (hi == 0) stt[eh * 128 + cl] = (f32x2){s1, s2};
    __syncthreads();
    const f32x2 o2 = stt[(eh ^ 1) * 128 + cl];
    const float mu = (s1 + o2[0]) * (1.f / 128.f), var = (s2 + o2[1]) * (1.f / 128.f) - mu * mu, rstd = __builtin_amdgcn_rsqf(fmaxf(var, 0.f) + EPS);
    const float* gg = a.in[9] + l * 512 + h * 128;
    bf16* gp = P + tok * NIN + 1536 + h * 128;
#pragma unroll
    for (int e = 0; e < 2; ++e)
#pragma unroll
        for (int pr = 0; pr < 2; ++pr) {
            unsigned wv[2][2];
#pragma unroll
            for (int k = 0; k < 2; ++k) {
                const int rq = 2 * pr + k, e0 = 64 * eh + 32 * e + 8 * rq + 4 * hi;
                const u32x2 sg = *(const u32x2*)(gp + e0); const f32x4 gv = *(const f32x4*)(gg + e0);
                const float y0 = (O[e][4 * rq + 0] - mu) * rstd * gv[0] * bflo(sg.x), y1 = (O[e][4 * rq + 1] - mu) * rstd * gv[1] * bfhi(sg.x);
                const float y2 = (O[e][4 * rq + 2] - mu) * rstd * gv[2] * bflo(sg.y), y3 = (O[e][4 * rq + 3] - mu) * rstd * gv[3] * bfhi(sg.y);
                wv[k][0] = pkbf(y0, y1); wv[k][1] = pkbf(y2, y3);
            }
            const auto sx = __builtin_amdgcn_permlane32_swap(wv[0][0], wv[1][0], false, false), sy = __builtin_amdgcn_permlane32_swap(wv[0][1], wv[1][1], false, false);
            u32x4 w; w.x = sx[0]; w.y = sy[0]; w.z = sx[1]; w.w = sy[1];
            if (!dry) *(u32x4*)(gp + 64 * eh + 32 * e + 16 * pr + 8 * hi) = w;
        }
    __syncthreads();
}

__device__ __forceinline__ void dattn_setup(const Args& a, LAS unsigned char* lds, int l, int tid, int lane) {
    const float* qg = a.in[10] + l * 128, * kg = a.in[11] + l * 128, * tb = a.in[14], * lv = a.in[12] + l * 256;
    const float mq = wave_max(fmaxf(fabsf(qg[lane]), fabsf(qg[64 + lane]))), mk = wave_max(fmaxf(fabsf(kg[lane]), fabsf(kg[64 + lane])));
    const float mb = wave_max(fmaxf(tb[lane], tb[64 + lane]));
    const float M = 8.f * mq * mk + mb;
    const float s0 = wave_sum(lv[lane] * lv[64 + lane]), s1 = wave_sum(lv[128 + lane] * lv[192 + lane]);
    const float lam_init = 0.8f - 0.6f * expf(-0.3f * (float)l);
    const float lam = expf(s0) - expf(s1) + lam_init;
    LAS float* tab = (LAS float*)(lds + LDS_TAB); LAS float* misc = (LAS float*)(lds + LDS_MISC);
    for (int i = tid; i < 4 * 321; i += 512) { const int h = i / 321, k = i % 321; tab[i] = (tb[rel_bucket(k - 160) * 4 + h] - M) * LOG2E; }
    if (tid == 0) { misc[0] = lam; misc[1] = 1.f - lam_init; }
    __syncthreads();
}
#define DA_LOAD(kt) do { _Pragma("unroll") for (int i_ = 0; i_ < 2; ++i_) { const int c_ = tid + 512 * i_, row_ = c_ >> 4, ch_ = c_ & 15; \
        kr[i_] = *(const u32x4*)(kbase + (size_t)((kt) * 64 + row_) * NIN + ch_ * 8); vr[i_] = *(const u32x4*)(kbase + 512 + (size_t)((kt) * 64 + row_) * NIN + ch_ * 8); } } while (0)
#define DA_STORE(buf) do { _Pragma("unroll") for (int i_ = 0; i_ < 2; ++i_) { const int c_ = tid + 512 * i_, row_ = c_ >> 4, ch_ = c_ & 15; const unsigned o_ = offb(row_, ch_); \
        *(LAS u32x4*)(lds + (buf) * 32768 + o_) = kr[i_]; *(LAS u32x4*)(lds + (buf) * 32768 + 16384 + o_) = vr[i_]; } } while (0)
__device__ __forceinline__ void dattn_unit(const Args& a, unsigned char* ws, LAS unsigned char* lds, int l, int unit, int tid, int wid, int lane, int dry) {
    asm volatile("" : "+v"(lane), "+v"(tid));
    const int qb = unit & 15, h = (unit >> 4) & 3, b = unit >> 6;
    const int r32 = lane & 31, hi = lane >> 5, g1 = (lane >> 4) & 1, q4 = (lane & 15) >> 2, p4 = lane & 3;
    const int t = wid & 1, rg = wid >> 1;
    const int qw = qb * 128 + rg * 32;
    bf16* P = (bf16*)(ws + WS_P);
    const size_t tok = (size_t)b * SEQ + qw + r32;
    const LAS float* tab = (const LAS float*)(lds + LDS_TAB) + h * 321;
    const LAS float* misc = (const LAS float*)(lds + LDS_MISC);
    bf16x8 qf[4];
#pragma unroll
    for (int d0 = 0; d0 < 4; ++d0) qf[d0] = *(const bf16x8*)(P + tok * NIN + 2048 + h * 128 + t * 64 + 16 * d0 + 8 * hi);
    const bf16* kbase = P + (size_t)b * SEQ * NIN + 2560 + h * 128;
    f32x16 O[4];
#pragma unroll
    for (int eb = 0; eb < 4; ++eb)
#pragma unroll
        for (int r = 0; r < 16; ++r) O[eb][r] = 0.f;
    float lsum = 0.f;
    const float bneg = tab[0], bpos = tab[320];
    unsigned vp[4][2], kb[4];
#pragma unroll
    for (int c = 0; c < 4; ++c) { vp[c][0] = tr_base_perm(c, 0, lane); vp[c][1] = tr_base_perm(c, 1, lane); kb[c] = row_base(8 * t + 2 * c, lane); }
    const int rot = 2 * qb;
    int dsrc[2];
#pragma unroll
    for (int i = 0; i < 2; ++i) { const int p = (2 * wid + i) * 64 + lane, row = p >> 4, ch = (p & 15) ^ (((row & 3) << 2) | ((row >> 2) & 3)); dsrc[i] = row * NIN + ch * 8; }
#define DA_DMAK(kt, slot) do { _Pragma("unroll") for (int i_ = 0; i_ < 2; ++i_) __builtin_amdgcn_global_load_lds((const unsigned*)(kbase + (size_t)((((kt) + rot) & 31) * 64) * NIN + dsrc[i_]), \
        (LAS unsigned*)(lds + (slot) * 32768 + (2 * wid + i_) * 1024), 16, 0, 0); } while (0)
#define DA_DMAV(kt, slot) do { _Pragma("unroll") for (int i_ = 0; i_ < 2; ++i_) __builtin_amdgcn_global_load_lds((const unsigned*)(kbase + 512 + (size_t)((((kt) + rot) & 31) * 64) * NIN + dsrc[i_]), \
        (LAS unsigned*)(lds + (slot) * 32768 + 16384 + (2 * wid + i_) * 1024), 16, 0, 0); } while (0)
#define DA_WAITBAR() asm volatile("s_waitcnt vmcnt(0) lgkmcnt(0)\n\ts_barrier" ::: "memory")
#define DA_QK(kt, slot, SN) do { \
        const LAS unsigned char* KT_ = lds + (slot) * 32768; \
        bf16x8 kf_[2][4]; \
        _Pragma("unroll") for (int blk = 0; blk < 2; ++blk) _Pragma("unroll") for (int d0 = 0; d0 < 4; ++d0) kf_[blk][d0] = *(const LAS bf16x8*)(KT_ + kb[d0] + 8192 * blk); \
        _Pragma("unroll") for (int blk = 0; blk < 2; ++blk) { \
            const int k0_ = (((kt) + rot) & 31) * 64 + blk * 32, relmax_ = k0_ + 31 - qw, relmin_ = k0_ - qw - 31; \
            const float cinit_ = (relmax_ <= -91) ? bneg : ((relmin_ >= 91) ? bpos : 0.f); \
            _Pragma("unroll") for (int r = 0; r < 16; ++r) SN[blk][r] = cinit_; \
            _Pragma("unroll") for (int d0 = 0; d0 < 4; ++d0) SN[blk] = __builtin_amdgcn_mfma_f32_32x32x16_bf16(kf_[blk][d0], qf[d0], SN[blk], 0, 0, 0); \
        } } while (0)
#define DA_SB() __builtin_amdgcn_sched_barrier(0)
#define DA_VRD(blk, j) tr_pair(VT_ + vp[(j) & 3][0] + 256 * (32 * (blk) + 16 * ((j) >> 2)), VT_ + vp[(j) & 3][1] + 256 * (32 * (blk) + 16 * ((j) >> 2) + 8))
#define DA_STEP(kt, par, SC, SN, HAS_K2, HAS_V1, HAS_QK) do { \
        if (HAS_K2) DA_DMAK((kt) + 2, par); \
        if (HAS_V1) DA_DMAV((kt) + 1, (par) ^ 1); \
        const LAS unsigned char* KT_ = lds + ((par) ^ 1) * 32768; const LAS unsigned char* VT_ = lds + (par) * 32768 + 16384; \
        bf16x8 kf_[2][4], vf_[8]; \
        if (HAS_QK) { \
            _Pragma("unroll") for (int blk = 0; blk < 2; ++blk) _Pragma("unroll") for (int d0 = 0; d0 < 4; ++d0) kf_[blk][d0] = *(const LAS bf16x8*)(KT_ + kb[d0] + 8192 * blk); \
            _Pragma("unroll") for (int blk = 0; blk < 2; ++blk) { \
                const int k0_ = (((kt) + 1 + rot) & 31) * 64 + blk * 32, relmax_ = k0_ + 31 - qw, relmin_ = k0_ - qw - 31; \
                const float cinit_ = (relmax_ <= -91) ? bneg : ((relmin_ >= 91) ? bpos : 0.f); \
                _Pragma("unroll") for (int r = 0; r < 16; ++r) SN[blk][r] = cinit_; } \
        } \
        _Pragma("unroll") for (int blk = 0; blk < 2; ++blk) { \
            const int k0_ = (((kt) + rot) & 31) * 64 + blk * 32, relmax_ = k0_ + 31 - qw, relmin_ = k0_ - qw - 31; \
            if (!(relmax_ <= -91 || relmin_ >= 91)) { \
                const LAS float* tb_ = tab + (k0_ - qw - r32 + 4 * hi + 160);     \
                _Pragma("unroll") for (int r = 0; r < 16; ++r) SC[blk][r] += tb_[(r & 3) + 8 * (r >> 2)]; \
            } } \
        DA_SB(); \
        _Pragma("unroll") for (int j = 0; j < 8; ++j) { \
            if (HAS_QK) SN[j >> 2] = __builtin_amdgcn_mfma_f32_32x32x16_bf16(kf_[j >> 2][j & 3], qf[j & 3], SN[j >> 2], 0, 0, 0); \
            SC[0][2 * j] = __builtin_amdgcn_exp2f(SC[0][2 * j]); SC[0][2 * j + 1] = __builtin_amdgcn_exp2f(SC[0][2 * j + 1]); \
            vf_[j] = DA_VRD(0, j); \
            DA_SB(); } \
        const bf16x8 pk00_ = pack8(SC[0], 0), pk01_ = pack8(SC[0], 1); \
        DA_SB(); \
        _Pragma("unroll") for (int j = 0; j < 8; ++j) { \
            O[j & 3] = __builtin_amdgcn_mfma_f32_32x32x16_bf16(vf_[j], (j >> 2) ? pk01_ : pk00_, O[j & 3], 0, 0, 0); \
            SC[1][2 * j] = __builtin_amdgcn_exp2f(SC[1][2 * j]); SC[1][2 * j + 1] = __builtin_amdgcn_exp2f(SC[1][2 * j + 1]); \
            lsum += SC[0][2 * j] + SC[0][2 * j + 1]; \
            vf_[j] = DA_VRD(1, j); \
            DA_SB(); } \
        const bf16x8 pk10_ = pack8(SC[1], 0), pk11_ = pack8(SC[1], 1); \
        DA_SB(); \
        _Pragma("unroll") for (int j = 0; j < 8; ++j) { \
            O[j & 3] = __builtin_amdgcn_mfma_f32_32x32x16_bf16(vf_[j], (j >> 2) ? pk11_ : pk10_, O[j & 3], 0, 0, 0); \
            lsum += SC[1][2 * j] + SC[1][2 * j + 1]; \
            DA_SB(); } \
        DA_WAITBAR(); } while (0)
    f32x16 SA[2], SB[2];
    DA_DMAK(0, 0); DA_DMAV(0, 0); DA_DMAK(1, 1);
    DA_WAITBAR();
    DA_QK(0, 0, SA);
    DA_WAITBAR();
    for (int kt = 0; kt < 30; kt += 2) { DA_STEP(kt, 0, SA, SB, true, true, true); DA_STEP(kt + 1, 1, SB, SA, true, true, true); }
    DA_STEP(30, 0, SA, SB, false, true, true);
    DA_STEP(31, 1, SB, SA, false, false, false);
#undef DA_SB
#undef DA_VRD
#undef DA_STEP
#undef DA_QK
#undef DA_DMAK
#undef DA_DMAV
#undef DA_WAITBAR
    lsum += __shfl_xor(lsum, 32);
    const float lam = misc[0], oneml = misc[1];
    LAS float* Y = (LAS float*)lds + rg * 4096;
    if (t == 1) {
        const float inv = lam / lsum;
#pragma unroll
        for (int eb = 0; eb < 4; ++eb)
#pragma unroll
            for (int r = 0; r < 16; ++r) Y[(32 * eb + crow(r, hi)) * 32 + r32] = O[eb][r] * inv;
    }
    __syncthreads();
    if (t == 0 && !dry) {
        const float inv = 1.f / lsum; float ssq = 0.f;
#pragma unroll
        for (int eb = 0; eb < 4; ++eb)
#pragma unroll
            for (int r = 0; r < 16; ++r) { const float o = O[eb][r] * inv - Y[(32 * eb + crow(r, hi)) * 32 + r32]; O[eb][r] = o; ssq += o * o; }
        ssq += __shfl_xor(ssq, 32);
        const float rs = __builtin_amdgcn_rsqf(ssq * (1.f / 128.f) + EPS) * oneml;
        const float* sg = a.in[13] + l * 128;
        bf16* op = P + tok * NIN + 2048 + h * 128;
#pragma unroll
        for (int eb = 0; eb < 4; ++eb)
#pragma unroll
            for (int pr = 0; pr < 2; ++pr) {
                u32x2 wa, wb;
                { const int rq = 2 * pr, e0 = 32 * eb + 8 * rq + 4 * hi; const f32x4 gv = *(const f32x4*)(sg + e0);
                  wa.x = pkbf(O[eb][4 * rq] * rs * gv[0], O[eb][4 * rq + 1] * rs * gv[1]); wa.y = pkbf(O[eb][4 * rq + 2] * rs * gv[2], O[eb][4 * rq + 3] * rs * gv[3]); }
                { const int rq = 2 * pr + 1, e0 = 32 * eb + 8 * rq + 4 * hi; const f32x4 gv = *(const f32x4*)(sg + e0);
                  wb.x = pkbf(O[eb][4 * rq] * rs * gv[0], O[eb][4 * rq + 1] * rs * gv[1]); wb.y = pkbf(O[eb][4 * rq + 2] * rs * gv[2], O[eb][4 * rq + 3] * rs * gv[3]); }
                const auto sx = __builtin_amdgcn_permlane32_swap(wa.x, wb.x, false, false), sy = __builtin_amdgcn_permlane32_swap(wa.y, wb.y, false, false);
                u32x4 w; w.x = sx[0]; w.y = sy[0]; w.z = sx[1]; w.w = sy[1];
                *(u32x4*)(op + 32 * eb + 16 * pr + 8 * hi) = w;
            }
    }
    __syncthreads();
}

#define XB_TMO      128
#define XB_XCNT(j)  (256  + 64 * (j))
#define XB_XSUB(j)  (1280 + 64 * (j))
#define XB_XGEN(j)  (2304 + 64 * (j))
#define XB_TOP      3328
#define XB_TOPGEN   3392
#define XCD_BAR_WORDS 3456
#define XB_SPIN_CAP (1u << 18)

__device__ __forceinline__ unsigned xb_ld(unsigned* p)              { return __hip_atomic_load(p, __ATOMIC_RELAXED, __HIP_MEMORY_SCOPE_AGENT); }
__device__ __forceinline__ unsigned xb_add(unsigned* p, unsigned v) { return __hip_atomic_fetch_add(p, v, __ATOMIC_RELAXED, __HIP_MEMORY_SCOPE_AGENT); }
__device__ __forceinline__ unsigned xb_xcc_id() { return (unsigned)__builtin_amdgcn_s_getreg((3 << 11) | 20) & 0xFu; }
#define XB_SPIN(cond, bar) do { unsigned _sp = 0; while (cond) { __builtin_amdgcn_s_sleep(1); \
    if ((++_sp & 255u) == 0u) { if (xb_ld(&(bar)[XB_TMO])) break; if (_sp > XB_SPIN_CAP) { atomicAdd(&(bar)[XB_TMO], 1u); break; } } } } while (0)

struct XcdBarrier {
    unsigned* bar; unsigned x;
    volatile LAS unsigned* st;
};

__device__ __forceinline__ XcdBarrier xcd_barrier_post(unsigned* bar, volatile LAS unsigned* st) {
    XcdBarrier b; b.bar = bar; b.x = xb_xcc_id(); b.st = st;
    if (threadIdx.x == 0) (void)xb_add(&bar[XB_XCNT(b.x)], 1u);
    return b;
}
__device__ __forceinline__ void xcd_barrier_complete(unsigned* bar, unsigned x, unsigned& nloc, unsigned& nx) {
    const unsigned G = gridDim.x * gridDim.y * gridDim.z;
    unsigned sum, cnt, mine, sp = 0u;
    for (;;) {
        sum = 0u; cnt = 0u; mine = 0u;
#pragma unroll
        for (unsigned j = 0; j < 16; ++j) { const unsigned c = xb_ld(&bar[XB_XCNT(j)]); sum += c; cnt += (c > 0u) ? 1u : 0u; mine = (j == x) ? c : mine; }
        if (sum == G) break;
        __builtin_amdgcn_s_sleep(1);
        if ((++sp & 255u) == 0u) { if (xb_ld(&bar[XB_TMO])) break; if (sp > XB_SPIN_CAP) { atomicAdd(&bar[XB_TMO], 1u); break; } }
    }
    nloc = mine > 0u ? mine : 1u; nx = cnt > 0u ? cnt : 1u;
}

__device__ __forceinline__ void xcd_barrier(const XcdBarrier& b) {
    asm volatile("s_waitcnt vmcnt(0)" ::: "memory");
    __syncthreads();
    if (threadIdx.x == 0) {
        unsigned* bar = b.bar;
        __builtin_amdgcn_s_waitcnt(0);
        unsigned nloc = b.st[0], nx = b.st[1];
        if (nloc == 0u) { xcd_barrier_complete(bar, b.x, nloc, nx); b.st[0] = nloc; b.st[1] = nx; }
        const unsigned old = xb_add(&bar[XB_XSUB(b.x)], 1u);
        const unsigned gen = old / nloc;
        if (old + 1u == (gen + 1u) * nloc) {
            __builtin_amdgcn_fence(__ATOMIC_RELEASE, "agent");
            asm volatile("s_waitcnt vmcnt(0)" ::: "memory");
            const unsigned og = xb_add(&bar[XB_TOP], 1u);
            const unsigned tg = og / nx;
            if (og + 1u == (tg + 1u) * nx) xb_add(&bar[XB_TOPGEN], 1u);
            else XB_SPIN(xb_ld(&bar[XB_TOPGEN]) == tg, bar);
            __builtin_amdgcn_fence(__ATOMIC_ACQUIRE, "agent");
            xb_add(&bar[XB_XGEN(b.x)], 1u);
            asm volatile("s_waitcnt vmcnt(0)" ::: "memory");
        } else {
            XB_SPIN(xb_ld(&bar[XB_XGEN(b.x)]) == gen, bar);
            __builtin_amdgcn_fence(__ATOMIC_ACQUIRE, "agent");
            asm volatile("s_waitcnt vmcnt(0)" ::: "memory");
        }
    }
    __syncthreads();
}

#ifndef PROBE_DUP
#define PROBE_DUP 0
#endif
template <int PHM, int PH> __device__ __forceinline__ void run_phase(const Args& a, LAS unsigned char* lds0, int dry) {
    int tid = threadIdx.x; asm volatile("" : "+v"(tid));
    const int lane = tid & 63, wid = __builtin_amdgcn_readfirstlane(tid >> 6);
    int z_; asm volatile("s_mov_b32 %0, 0" : "=s"(z_));
    unsigned char* ws = a.ws + z_;
    LAS unsigned char* lds = lds0 + z_;
    const int G = (int)gridDim.x + z_, bx = (int)blockIdx.x + z_;
    const int vcu = (G % 8 == 0) ? (bx % 8) * (G / 8) + bx / 8 : bx;
    float* outp = (float*)((unsigned char*)a.out + z_);
    u64* stat = (u64*)(ws + WS_STAT); bf16* hb = (bf16*)(ws + WS_HB); bf16* P = (bf16*)(ws + WS_P);
    if constexpr (PH == 0) { if constexpr ((PHM & 1) != 0) phase_prep(a, ws, lds, vcu, G, tid, wid, lane); }
    else {
        constexpr int l = (PH - 1) / 10, sp = (PH - 1) % 10;
        unsigned char* wl = ws + WS_W + (size_t)l * W_LAYER;
        if constexpr ((PHM & 2) != 0 && (sp == 0 || sp == 7)) {
            pg8::Gemm g{hb, (const bf16*)(wl + (sp == 0 ? WO_GU1 : WO_GU2)), T, 2 * FF, DM, DM};
            pg8::StaticOrder S; S.init(T, 2 * FF, G, bx);
            constexpr bool NN = (l > 0 && sp == 0);
            EpiSwiGLU<NN> E{P, stat + (size_t)(NN ? (l - 1) * 4 + 3 : l * 4 + (sp == 0 ? 0 : 2)) * T, stat + (size_t)(l * 4) * T};
            pg8::gemm_phase<EpiSwiGLU<NN>, pg8::StaticOrder, true, true>(lds, g, S, E, tid);
        } else if constexpr ((PHM & 4) != 0 && (sp == 1 || sp == 8 || sp == 6)) {
            pg8::Gemm g{sp == 6 ? P + 1536 : P, (const bf16*)(wl + (sp == 1 ? WO_D1 : (sp == 8 ? WO_D2 : WO_OUT))), T, DM, sp == 6 ? DM : FF, sp == 6 ? NIN : FF};
            pg8::StaticOrder S; S.init(T, DM, G, bx);
            constexpr int MODE = (sp == 8 && l + 1 < 2) ? 1 : ((sp == 1 && l > 0) ? 2 : 0);
            constexpr int lg = (MODE == 1) ? l : (l > 0 ? l - 1 : 0);
            constexpr bool WF32 = false;
            EpiRes<MODE, WF32> E{outp, hb, stat + (size_t)(l * 4 + (sp == 1 ? 1 : (sp == 6 ? 2 : 3))) * T, dry,
                           a.in[20] + lg * DM, stat + (size_t)(lg * 4 + 3) * T, stat + (size_t)((l + 1) * 4) * T};
            pg8::gemm_phase<EpiRes<MODE, WF32>, pg8::StaticOrder, true, true>(lds, g, S, E, tid);
        } else if constexpr ((PHM & 8) != 0 && sp == 2) {
            pg8::Gemm g{hb, (const bf16*)(wl + WO_IN), T, NIN, DM, DM};
            pg8::StaticOrder S; S.init(T, NIN, G, bx);
            EpiWin E{P, stat + (size_t)(l * 4 + 1) * T, (const f32x2*)(ws + WS_ROT), a.in[10] + l * 128, a.in[11] + l * 128};
            pg8::gemm_phase<EpiWin, pg8::StaticOrder, true, true>(lds, g, S, E, tid);
        } else if constexpr ((PHM & 16) != 0 && sp == 3) {
            for (int u = vcu; u < NB * 64; u += G) r1_unit(a, ws, (bf16*)outp, lds, l, u, tid, wid, lane);
        } else if constexpr ((PHM & 32) != 0 && sp == 4) {
            phase_scan(a, ws, (bf16*)outp, l, vcu, G, tid, z_);
        } else if constexpr (sp == 5) {
            if constexpr ((PHM & 64) != 0) { dattn_setup(a, lds, l, tid, lane);
                for (int u = vcu; u < NB * 64; u += G) dattn_unit(a, ws, lds, l, u, tid, wid, lane, dry); }
            if constexpr ((PHM & 128) != 0) { for (int u = vcu; u < NB * 64; u += G) r2_unit(a, ws, (bf16*)outp, lds, l, u, tid, wid, lane, dry); }
        } else if constexpr ((PHM & 256) != 0 && sp == 9 && l == 1) {
            phase_fnorm(a, ws, outp, l, vcu, G, wid, lane);
        }
    }
}
template <int PHM> __global__ void __launch_bounds__(512) fwd_kernel(Args a0) {
    extern __shared__ __attribute__((aligned(16))) unsigned char lds_raw[];
    LAS unsigned char* lds0 = (LAS unsigned char*)lds_raw;
    cg::grid_group grid = cg::this_grid();
    const int lo = a0.lo, hi = a0.hi;
    if (threadIdx.x < 2) ((LAS unsigned*)(lds0 + LDS_BARW))[threadIdx.x] = 0u;
    __syncthreads();
    XcdBarrier xbar; xbar.bar = (unsigned*)(a0.ws + WS_BAR); xbar.x = 0; xbar.st = (volatile LAS unsigned*)(lds0 + LDS_BARW);
    if (hi - lo > 1) xbar = xcd_barrier_post((unsigned*)(a0.ws + WS_BAR), (volatile LAS unsigned*)(lds0 + LDS_BARW));
#define RUN(k) if ((k) != 10 && lo <= (k) && (k) < hi) { run_phase<PHM, (k)>(a0, lds0, a0.dry); if ((k) + 1 < hi) { if ((k) == 0) grid.sync(); else xcd_barrier(xbar); } }
    RUN(0) RUN(1) RUN(2) RUN(3) RUN(4) RUN(5) RUN(6) RUN(7) RUN(8) RUN(9) RUN(10)
    RUN(11) RUN(12) RUN(13) RUN(14) RUN(15) RUN(16) RUN(17) RUN(18) RUN(19) RUN(20)
#undef RUN
}

#ifndef N_LAUNCH_MODE
#define N_LAUNCH_MODE 1
#endif
template <int PHM> static void launch_one(const Args& a, int grid, hipStream_t stream) { hipLaunchKernelGGL(fwd_kernel<PHM>, dim3(grid), dim3(512), LDS_BYTES, stream, a); }
template <int PHM> static void set_lds() { (void)hipFuncSetAttribute((const void*)fwd_kernel<PHM>, hipFuncAttributeMaxDynamicSharedMemorySize, LDS_BYTES); }
extern "C" void kernel_launch(void* const* d_in, const int* in_sizes, int n_in, void* d_out, int out_size, void* d_ws, size_t ws_size, hipStream_t stream) {
    static int grid = 0;
    if (grid == 0) {
        if (n_in != 21 || ws_size < WS_END) { fprintf(stderr, "kernel_launch: unexpected inputs (n_in %d, ws %zu)\n", n_in, ws_size); grid = -1; return; }
        int dev = 0, cus = 0, per_cu = 0;
        (void)hipGetDevice(&dev); (void)hipDeviceGetAttribute(&cus, hipDeviceAttributeMultiprocessorCount, dev);
#if N_LAUNCH_MODE == 1
        set_lds<511>();
        (void)hipOccupancyMaxActiveBlocksPerMultiprocessor(&per_cu, (const void*)fwd_kernel<511>, 512, LDS_BYTES);
#else
        set_lds<1>(); set_lds<2>(); set_lds<4>(); set_lds<8>(); set_lds<16>(); set_lds<32>(); set_lds<64>(); set_lds<128>(); set_lds<256>();
        per_cu = 1;
#endif
        if (per_cu < 1) { fprintf(stderr, "kernel_launch: occupancy query returned %d\n", per_cu); per_cu = 1; }
        (void)hipGetLastError();
        grid = cus * per_cu;
    }
    if (grid < 0) return;
    Args a{};
    for (int i = 0; i < 21; ++i) a.in[i] = (const float*)d_in[i];
    a.out = (float*)d_out; a.ws = (unsigned char*)d_ws;
#if N_LAUNCH_MODE == 1
    (void)hipMemsetAsync((unsigned char*)d_ws + WS_BAR, 0, WS_BAR_BYTES, stream);
    a.lo = 0; a.hi = NPHASE;
    void* args[] = {&a};
    hipError_t e = hipLaunchCooperativeKernel((const void*)fwd_kernel<511>, dim3(grid), dim3(512), args, LDS_BYTES, stream);
    if (e != hipSuccess) fprintf(stderr, "cooperative launch failed: %s (grid %d)\n", hipGetErrorString(e), grid);
#else
    for (int ph = 0; ph < NPHASE; ++ph) {
        a.lo = ph; a.hi = ph + 1;
        const int sp = ph == 0 ? 11 : (ph - 1) % 10;
        const int nrep = 1 + ((PROBE_DUP >> sp) & 1), nrepB = 1 + ((PROBE_DUP >> 10) & 1);
        for (int rep = 0; rep < nrep; ++rep) {
            a.dry = (rep + 1 < nrep) ? 1 : 0;
            if (ph == 0) launch_one<1>(a, grid, stream);
            else if (sp == 0 || sp == 7) launch_one<2>(a, grid, stream);
            else if (sp == 1 || sp == 8 || sp == 6) launch_one<4>(a, grid, stream);
            else if (sp == 2) launch_one<8>(a, grid, stream);
            else if (sp == 3) launch_one<16>(a, grid, stream);
            else if (sp == 4) launch_one<32>(a, grid, stream);
            else if (sp == 5) { launch_one<64>(a, grid, stream); if (rep == 0) for (int rb = 0; rb < nrepB; ++rb) { Args b = a; b.dry = (rb + 1 < nrepB) ? 1 : 0; launch_one<128>(b, grid, stream); } }
            else launch_one<256>(a, grid, stream);
        }
    }
#endif
}
```
